# Optimizing an MI355X kernel written in HIP

```python
import math
import jax, jax.numpy as jnp
from jax import lax
import numpy as np

D_MODEL = 1024
BATCH = 16
SEQ = 2048
DEPTH = 2

POOL_GROUPS = 4
POOL_WINDOWS = (2, 4, 8, 16)
POOL_WIDTH = D_MODEL // 2
POOL_GROUP_DIM = POOL_WIDTH // POOL_GROUPS
N_HEADS = D_MODEL // 128
HEAD_DIM = 64
V_HEAD_DIM = 2 * HEAD_DIM
QK_WIDTH = N_HEADS * 2 * HEAD_DIM
V_WIDTH = N_HEADS * V_HEAD_DIM
ROPE_THETA = 500000.0
ROT_DIM = HEAD_DIM // 4
Q_BLOCK = 128
N_BRANCHES = 2
IN_WIDTH = POOL_WIDTH + 2 * QK_WIDTH + V_WIDTH + N_BRANCHES * D_MODEL
N_EXPERTS = 32
TOP_K = 4
D_FF = D_MODEL
SWIGLU_ALPHA = 1.702
SWIGLU_LIMIT = 7.0
EXPERT_BLOCK = 128
LN_EPS = 1e-5
DEEPNORM_ALPHA = (2 * DEPTH) ** 0.25
DEEPNORM_BETA = (8 * DEPTH) ** -0.25

kernel_name = 'pool_diffattn_gated_moe_deepnorm'


def layer_norm(x, g, b):
    xf = x.astype(jnp.float32)
    mu = jnp.mean(xf, axis=-1, keepdims=True)
    var = jnp.mean(jnp.square(xf - mu), axis=-1, keepdims=True)
    return ((xf - mu) * lax.rsqrt(var + LN_EPS) * g + b).astype(x.dtype)


def rotary_tables(positions):
    inv_freq = ROPE_THETA ** (-jnp.arange(0, ROT_DIM, 2, dtype=jnp.float32) / ROT_DIM)
    ang = positions.astype(jnp.float32)[..., None] * inv_freq
    return jnp.cos(ang)[:, :, None, None, :], jnp.sin(ang)[:, :, None, None, :]


def partial_rotary(t, cos, sin):
    half = ROT_DIM // 2
    tf = t[..., :ROT_DIM].astype(jnp.float32)
    t1, t2 = tf[..., :half], tf[..., half:]
    rot = jnp.concatenate([t1 * cos - t2 * sin, t2 * cos + t1 * sin], axis=-1)
    return jnp.concatenate([rot.astype(t.dtype), t[..., ROT_DIM:]], axis=-1)


def multiscale_pool(u, w_grp, scale):
    B, S, _ = u.shape
    uf = u.reshape(B, S, POOL_GROUPS, POOL_GROUP_DIM).astype(jnp.float32)
    c = jnp.cumsum(uf, axis=1)
    means = []
    for g, w in enumerate(POOL_WINDOWS):
        cg = c[:, :, g]
        prev = jnp.pad(cg[:, :S - w], ((0, 0), (w, 0), (0, 0)))
        cnt = jnp.minimum(jnp.arange(1, S + 1), w).astype(jnp.float32)[None, :, None]
        means.append((cg - prev) / cnt)
    d = (jnp.stack(means, axis=2) - uf).astype(u.dtype)
    y = jnp.einsum('bsgc,gcd->bsgd', d, w_grp).reshape(B, S, POOL_WIDTH)
    return y * scale


def diff_attention(q, k, v, lam):
    B, S = q.shape[0], q.shape[1]
    nb = S // Q_BLOCK
    qb = q.reshape(B, nb, Q_BLOCK, N_HEADS, 2, HEAD_DIM).transpose(1, 0, 3, 4, 2, 5)
    kt = k.transpose(0, 2, 3, 1, 4)
    vt = v.transpose(0, 2, 1, 3)
    key_pos = jnp.arange(S)
    scale = HEAD_DIM ** -0.5

    def block(args):
        qblk, i = args
        s = jnp.einsum('bhmqd,bhmkd->bhmqk', qblk, kt).astype(jnp.float32) * scale
        qpos = i * Q_BLOCK + jnp.arange(Q_BLOCK)
        mask = key_pos[None, :] <= qpos[:, None]
        p = jax.nn.softmax(jnp.where(mask, s, -jnp.inf), axis=-1)
        a = (p[:, :, 0] - lam * p[:, :, 1]).astype(v.dtype)
        return jnp.einsum('bhqk,bhkv->bhqv', a, vt)

    o = lax.map(block, (qb, jnp.arange(nb)))
    return o.transpose(1, 0, 3, 2, 4).reshape(B, S, N_HEADS, V_HEAD_DIM)


def hybrid_mixer(x, cos, sin, layer, w_in, pool_w, pool_scale, w_pool_branch,
                 w_attn_branch, lq1, lk1, lq2, lk2, subln_w, w_out):
    B, S, D = x.shape
    proj = x @ w_in
    splits = [int(c) for c in np.cumsum([POOL_WIDTH, QK_WIDTH, QK_WIDTH, V_WIDTH])]
    u_pool, q, k, v, gates = jnp.split(proj, splits, axis=-1)
    y_pool = multiscale_pool(u_pool, pool_w, pool_scale) @ w_pool_branch
    q = partial_rotary(q.reshape(B, S, N_HEADS, 2, HEAD_DIM), cos, sin)
    k = partial_rotary(k.reshape(B, S, N_HEADS, 2, HEAD_DIM), cos, sin)
    v = v.reshape(B, S, N_HEADS, V_HEAD_DIM)
    lambda_init = 0.8 - 0.6 * math.exp(-0.3 * layer)
    lam = (jnp.exp(jnp.sum(lq1.astype(jnp.float32) * lk1.astype(jnp.float32)))
           - jnp.exp(jnp.sum(lq2.astype(jnp.float32) * lk2.astype(jnp.float32)))
           + lambda_init)
    o = diff_attention(q, k, v, lam).astype(jnp.float32)
    o = o * lax.rsqrt(jnp.mean(jnp.square(o), axis=-1, keepdims=True) + LN_EPS)
    o = (o * subln_w * (1.0 - lambda_init)).astype(x.dtype)
    y_attn = o.reshape(B, S, V_WIDTH) @ w_attn_branch
    g = jax.nn.sigmoid(gates.astype(jnp.float32)).astype(x.dtype).reshape(B, S, N_BRANCHES, D)
    merged = g[:, :, 0] * y_pool + g[:, :, 1] * y_attn
    return merged @ w_out


def moe_ffn(x2d, w_router, b_router, w_gu, b_gu, w_down, b_down):
    T, D = x2d.shape
    logits = (x2d @ w_router + b_router).astype(jnp.float32)
    top_val, top_idx = lax.top_k(logits, TOP_K)
    gate = jax.nn.softmax(top_val, axis=-1).astype(x2d.dtype)
    A = T * TOP_K
    flat_e = top_idx.reshape(A)
    order = jnp.argsort(flat_e)
    sorted_e = flat_e[order]
    counts = jnp.bincount(flat_e, length=N_EXPERTS)
    padded = (counts + EXPERT_BLOCK - 1) // EXPERT_BLOCK * EXPERT_BLOCK
    start = jnp.cumsum(counts) - counts
    pend = jnp.cumsum(padded)
    pstart = pend - padded
    dest = pstart[sorted_e] + jnp.arange(A) - start[sorted_e]
    n_blocks = -(-A // EXPERT_BLOCK) + N_EXPERTS
    rows = n_blocks * EXPERT_BLOCK
    row_tok = jnp.zeros((rows,), jnp.int32).at[dest].set((order // TOP_K).astype(jnp.int32))
    row_gate = jnp.zeros((rows,), x2d.dtype).at[dest].set(gate.reshape(A)[order])
    block_e = jnp.minimum(jnp.searchsorted(pend, jnp.arange(n_blocks) * EXPERT_BLOCK, side='right'),
                          N_EXPERTS - 1)
    xs = x2d[row_tok].reshape(n_blocks, EXPERT_BLOCK, D)

    def expert_block(args):
        xb, e = args
        h = xb @ w_gu[e] + b_gu[e]
        hg = jnp.minimum(h[:, :D_FF], SWIGLU_LIMIT)
        hu = jnp.clip(h[:, D_FF:], -SWIGLU_LIMIT, SWIGLU_LIMIT)
        act = (hu + 1.0) * hg * jax.nn.sigmoid(SWIGLU_ALPHA * hg)
        return act @ w_down[e] + b_down[e]

    ys = lax.map(expert_block, (xs, block_e)).reshape(rows, D)
    return jnp.zeros_like(x2d).at[row_tok].add(row_gate[:, None] * ys)


def setup_inputs(seed: int = 0) -> dict:
    key = jax.random.key(seed)
    ks = jax.random.split(key, 24)

    def nrm(k, shape, scale):
        return jax.random.normal(k, shape, jnp.float32) * scale

    L, D, E, F = DEPTH, D_MODEL, N_EXPERTS, D_FF
    v_lo = POOL_WIDTH + 2 * QK_WIDTH
    w_in = nrm(ks[2], (L, D, IN_WIDTH), D ** -0.5)
    w_in = w_in.at[:, :, v_lo:v_lo + V_WIDTH].multiply(DEEPNORM_BETA)
    return {
        'x': nrm(ks[0], (BATCH, SEQ, D), 1.0),
        'positions': jnp.broadcast_to(jnp.arange(SEQ, dtype=jnp.int32), (BATCH, SEQ)),
        'w_in': w_in,
        'pool_w': nrm(ks[3], (L, POOL_GROUPS, POOL_GROUP_DIM, POOL_GROUP_DIM), POOL_GROUP_DIM ** -0.5),
        'pool_scale': 1.0 + nrm(ks[4], (L, POOL_WIDTH), 0.02),
        'w_pool_branch': nrm(ks[5], (L, POOL_WIDTH, D), POOL_WIDTH ** -0.5),
        'w_attn_branch': nrm(ks[6], (L, V_WIDTH, D), V_WIDTH ** -0.5),
        'lambda_q1': nrm(ks[7], (L, HEAD_DIM), 0.1),
        'lambda_k1': nrm(ks[8], (L, HEAD_DIM), 0.1),
        'lambda_q2': nrm(ks[9], (L, HEAD_DIM), 0.1),
        'lambda_k2': nrm(ks[10], (L, HEAD_DIM), 0.1),
        'subln_w': 1.0 + nrm(ks[11], (L, V_HEAD_DIM), 0.02),
        'w_out': nrm(ks[12], (L, D, D), D ** -0.5 * DEEPNORM_BETA),
        'ln1_g': 1.0 + nrm(ks[13], (L, D), 0.02),
        'ln1_b': nrm(ks[14], (L, D), 0.02),
        'w_router': nrm(ks[15], (L, D, E), D ** -0.5),
        'b_router': nrm(ks[16], (L, E), 0.01),
        'w_gu': nrm(ks[17], (L, E, D, 2 * F), D ** -0.5 * DEEPNORM_BETA),
        'b_gu': nrm(ks[18], (L, E, 2 * F), 0.02),
        'w_down': nrm(ks[19], (L, E, F, D), F ** -0.5 * DEEPNORM_BETA),
        'b_down': nrm(ks[20], (L, E, D), 0.02),
        'ln2_g': 1.0 + nrm(ks[21], (L, D), 0.02),
        'ln2_b': nrm(ks[22], (L, D), 0.02),
    }


def reference(x, positions, w_in, pool_w, pool_scale, w_pool_branch, w_attn_branch,
              lambda_q1, lambda_k1, lambda_q2, lambda_k2, subln_w, w_out, ln1_g, ln1_b,
              w_router, b_router, w_gu, b_gu, w_down, b_down, ln2_g, ln2_b):
    B, S, D = x.shape
    cos, sin = rotary_tables(positions)
    for l in range(DEPTH):
        mix = hybrid_mixer(x, cos, sin, l, w_in[l], pool_w[l], pool_scale[l], w_pool_branch[l],
                           w_attn_branch[l], lambda_q1[l], lambda_k1[l], lambda_q2[l],
                           lambda_k2[l], subln_w[l], w_out[l])
        x = layer_norm(DEEPNORM_ALPHA * x + mix, ln1_g[l], ln1_b[l])
        ffn = moe_ffn(x.reshape(B * S, D), w_router[l], b_router[l], w_gu[l], b_gu[l],
                      w_down[l], b_down[l]).reshape(B, S, D)
        x = layer_norm(DEEPNORM_ALPHA * x + ffn, ln2_g[l], ln2_b[l])
    return x
```

```cpp
#include <hip/hip_runtime.h>
#include <hip/hip_bf16.h>
#include <cstdio>
#include <cstdint>
#include <cmath>

#ifndef PROBE_PHASE
#define PROBE_PHASE -1
#endif
#ifndef ATTN_EXTRA_QB
#define ATTN_EXTRA_QB -1
#endif
#ifndef REP_ATTN
#define REP_ATTN 1
#endif
#ifndef MK_MULTI
#define MK_MULTI 0
#endif

namespace pg8 {
#define PG8_LAS __attribute__((address_space(3)))
typedef unsigned short bf16_t;
typedef short bf16x8 __attribute__((ext_vector_type(8)));
typedef float f32x4 __attribute__((ext_vector_type(4)));
typedef unsigned u32x4 __attribute__((ext_vector_type(4)));
typedef unsigned u32x2 __attribute__((ext_vector_type(2)));
typedef int i32x4 __attribute__((ext_vector_type(4)));
typedef int i32x8 __attribute__((ext_vector_type(8)));
typedef float f32x8 __attribute__((ext_vector_type(8)));
constexpr int BM = 256, BK = 64, HALF = 128, HTB = HALF * BK * 2, STAGE_BYTES = 8 * HTB, NXCD = 8, WGM = 8;

__host__ __device__ __forceinline__ int lds_byte(int r, int c) { const int st = (r >> 4) * 2 + (c >> 5), rr = r & 15, cc = c & 31, ob = rr * 64 + cc * 2; return st * 1024 + (ob ^ (((ob >> 9) & 1) << 5)); }
__host__ __device__ __forceinline__ void stage_rc(int b, int& R, int& C) { const int st = b / 1024, sb = b % 1024, swz = sb ^ (((sb >> 9) & 1) << 5); R = (st >> 1) * 16 + swz / 64; C = (st & 1) * 32 + (swz % 64) / 2; }
__host__ __device__ __forceinline__ int perm32(int rho) { const int n = rho >> 4, i = rho & 15; return 8 * (i >> 2) + 4 * n + (i & 3); }

struct Unit { int pm, pn, e, r0, cnt; };
struct Gemm { const bf16_t* A; const bf16_t* Bt; int M, N, K; };

struct StaticOrder {
    int nM, nN, nwg, G, c;
    __host__ __device__ void init(int M, int N, int G_, int c_) { nM = M / BM; nN = N / BM; nwg = nM * nN; G = G_; c = c_; }
    __host__ __device__ bool next(int i, Unit& u) const {
        const long L = (long)i * G + c; if (L >= nwg) return false;
        int wgid = (int)L; { const int q = nwg / NXCD, r = nwg % NXCD, xcd = wgid % NXCD, off = wgid / NXCD; wgid = (xcd < r ? xcd * (q + 1) : r * (q + 1) + (xcd - r) * q) + off; }
        const int nig = WGM * nN, gid = wgid / nig, fm = gid * WGM, gsz = (nM - fm) < WGM ? (nM - fm) : WGM;
        u.pm = fm + ((wgid % nig) % gsz); u.pn = (wgid % nig) / gsz; u.e = 0; u.r0 = 0; u.cnt = 0; return true;
    }
    __device__ __forceinline__ int tok(const Unit&, int) const { return 0; }
};

struct TableOrder {
    const PG8_LAS int* tab; int n;
    __device__ __forceinline__ bool next(int i, Unit& u) const { if (i >= n) return false; u.pm = __builtin_amdgcn_readfirstlane(tab[i * 8]); u.pn = __builtin_amdgcn_readfirstlane(tab[i * 8 + 1]); u.e = 0; u.r0 = 0; u.cnt = 0; return true; }
    __device__ __forceinline__ int tok(const Unit&, int) const { return 0; }
};
constexpr int TAB_RB_REL = 48;
struct MoeOrder {
    const PG8_LAS int* blk;
    const PG8_LAS int* cnt;
    const int* rowtok;
    int ntl2, G, c, cap;
    __device__ __forceinline__ bool next(int i, Unit& u) const {
        const int L = i * G + c; const int nb = blk[32];
        if (L >= (nb << ntl2)) return false;
        const int rb = L >> ntl2, pn = L & ((1 << ntl2) - 1);
        const int e = blk[TAB_RB_REL + rb];
        u.e = e; u.pm = rb; u.pn = (e << ntl2) + pn; u.r0 = (rb - blk[e]) * 256; u.cnt = cnt[e]; return true;
    }
    __device__ __forceinline__ int tok(const Unit& u, int r) const { const int li = u.r0 + r; return li < u.cnt ? rowtok[(size_t)u.e * cap + li] : 0; }
};

__device__ __forceinline__ unsigned cvt_pk_bf16(float lo, float hi) { unsigned r; asm volatile("v_cvt_pk_bf16_f32 %0, %1, %2" : "=v"(r) : "v"(lo), "v"(hi)); return r; }
__device__ __forceinline__ unsigned cvt4_fp8(float a, float b, float c, float d) { int w = 0; w = __builtin_amdgcn_cvt_pk_fp8_f32(a, b, w, false); w = __builtin_amdgcn_cvt_pk_fp8_f32(c, d, w, true); return (unsigned)w; }
__device__ __forceinline__ float bf_lo(unsigned w) { return __uint_as_float(w << 16); }
__device__ __forceinline__ float bf_hi(unsigned w) { return __uint_as_float(w & 0xffff0000u); }

template <class Epi, class Sched, bool ALIGN_EPI = false, bool SP2 = false, bool GATHER = false, bool FP8 = false>
__device__ __forceinline__ void gemm_phase(PG8_LAS unsigned char* lds, const Gemm g, const Sched& S, const Epi& E) {
    int tid_ = threadIdx.x; asm volatile("" : "+v"(tid_) :: "memory");
    const int tid = tid_, wid = __builtin_amdgcn_readfirstlane(tid >> 6), lane = tid & 63, wr = wid >> 2, wc = wid & 3, fr = lane & 15, fq = lane >> 4;
    const int K = g.K, nt = K / BK;
    unsigned voffA[2], voffB[2]; int RA[2], CA[2];
#pragma unroll
    for (int i = 0; i < 2; ++i) { int R, C; stage_rc(tid * 16 + i * 8192, R, C); const int Rb = Epi::PERM ? ((R & ~31) + perm32(R & 31)) : R;
        RA[i] = R; CA[i] = C; voffA[i] = (unsigned)(R * K + C) * 2u; voffB[i] = (unsigned)(Rb * K + C) * 2u; }
    const size_t kstep = (size_t)(BK * 2);
    const size_t hstep = (size_t)HALF * K * 2;
    const size_t tstep = 2 * hstep;
    const size_t hstepA = GATHER ? 0 : hstep;
    const unsigned ldsw = (unsigned)wid * 1024u;
    const int aoff = lds_byte(wr * 64 + fr, fq * 8), boff = lds_byte(wc * 32 + fr, fq * 8);
#define PG8_SA(b, h) (((b) * 2 + (h)) * HTB)
#define PG8_SB(b, h) ((4 + (b) * 2 + (h)) * HTB)
#define PG8_STAGE(bufoff, gbase, voff) do { _Pragma("unroll") for (int _i = 0; _i < 2; ++_i) \
        __builtin_amdgcn_global_load_lds((const unsigned*)((const char*)(gbase) + (voff)[_i]), (PG8_LAS unsigned*)(lds + (bufoff) + ldsw + _i * 8192), 16, 0, 0); } while (0)
#define PG8_STAGE_A(bufoff, gbase, h, VO) do { _Pragma("unroll") for (int _i = 0; _i < 2; ++_i) \
        __builtin_amdgcn_global_load_lds((const unsigned*)((const char*)(gbase) + (h) * hstepA + (VO)[h][_i]), (PG8_LAS unsigned*)(lds + (bufoff) + ldsw + _i * 8192), 16, 0, 0); } while (0)
#define PG8_LDA(dst, b, h) do { _Pragma("unroll") for (int m = 0; m < 4; ++m) { if constexpr (FP8) { const i32x4 _lo = *(const PG8_LAS i32x4*)(lds + PG8_SA(b, h) + aoff + m * 2048), _hi = *(const PG8_LAS i32x4*)(lds + PG8_SA(b, h) + aoff + m * 2048 + 1024); \
            dst##8[m] = __builtin_shufflevector(_lo, _hi, 0, 1, 2, 3, 4, 5, 6, 7); } else { _Pragma("unroll") for (int k = 0; k < 2; ++k) dst[m][k] = *(const PG8_LAS bf16x8*)(lds + PG8_SA(b, h) + aoff + m * 2048 + k * 1024); } } } while (0)
#define PG8_LDB(dst, b, h) do { _Pragma("unroll") for (int n = 0; n < 2; ++n) { if constexpr (FP8) { const i32x4 _lo = *(const PG8_LAS i32x4*)(lds + PG8_SB(b, h) + boff + n * 2048), _hi = *(const PG8_LAS i32x4*)(lds + PG8_SB(b, h) + boff + n * 2048 + 1024); \
            dst##8[n] = __builtin_shufflevector(_lo, _hi, 0, 1, 2, 3, 4, 5, 6, 7); } else { _Pragma("unroll") for (int k = 0; k < 2; ++k) dst[n][k] = *(const PG8_LAS bf16x8*)(lds + PG8_SB(b, h) + boff + n * 2048 + k * 1024); } } } while (0)
#define PG8_MMA(ai, bj, At, Bt) do { __builtin_amdgcn_s_setprio(1); _Pragma("unroll") for (int m = 0; m < 4; ++m) _Pragma("unroll") for (int n = 0; n < 2; ++n) { \
        if constexpr (FP8) asm volatile("v_mfma_scale_f32_16x16x128_f8f6f4 %0, %1, %2, %0, %3, %3 op_sel_hi:[0,0,0]" : "+v"(acc[ai][bj][m][n]) : "v"(Bt##8[n]), "v"(At##8[m]), "v"(fp8_one)); \
        else { _Pragma("unroll") for (int k = 0; k < 2; ++k) acc[ai][bj][m][n] = __builtin_amdgcn_mfma_f32_16x16x32_bf16(Bt[n][k], At[m][k], acc[ai][bj][m][n], 0, 0, 0); } } \
        __builtin_amdgcn_s_setprio(0); } while (0)
#define PG8_WAIT_V(n) asm volatile("s_waitcnt vmcnt(" #n ")" ::: "memory")
#define PG8_WAIT_L(n) asm volatile("s_waitcnt lgkmcnt(" #n ")" ::: "memory")
#define PG8_BAR __builtin_amdgcn_s_barrier()
#define PG8_SCHED __builtin_amdgcn_sched_barrier(0)
#define PG8_GOFF(dst, unit) do { _Pragma("unroll") for (int _h = 0; _h < 2; ++_h) _Pragma("unroll") for (int _i = 0; _i < 2; ++_i) { \
        if constexpr (GATHER) { const int _t = S.tok(unit, _h * HALF + RA[_i]); dst[_h][_i] = (unsigned)(_t * K + CA[_i]) * 2u; } else dst[_h][_i] = voffA[_i]; } } while (0)
    Unit cur, nxt; int ui = 0;
    if (!S.next(0, cur)) return;
    f32x4 acc[2][2][4][2];
#pragma unroll
    for (int a = 0; a < 2; ++a)
#pragma unroll
        for (int b = 0; b < 2; ++b)
#pragma unroll
            for (int m = 0; m < 4; ++m)
#pragma unroll
                for (int n = 0; n < 2; ++n) acc[a][b][m][n] = (f32x4){0.f, 0.f, 0.f, 0.f};
    bf16x8 At[4][2], B0[2][2], B1[2][2]; i32x8 At8[4], B08[2], B18[2];
    const int fp8_one = 0x7F7F7F7F;
    unsigned voc[2][2], von[2][2];
    PG8_GOFF(voc, cur);
    const char* cA = GATHER ? (const char*)g.A : (const char*)g.A + (size_t)cur.pm * tstep; const char* cB = (const char*)g.Bt + (size_t)cur.pn * tstep;
    static_assert(SP2, "only the SP2 loop is kept in this file");
    PG8_STAGE(PG8_SB(0, 0), cB, voffB); PG8_STAGE(PG8_SB(0, 1), cB + hstep, voffB); PG8_STAGE_A(PG8_SA(0, 0), cA, 0, voc); PG8_STAGE_A(PG8_SA(0, 1), cA, 1, voc);
    if (wr == 1) PG8_BAR;
    PG8_WAIT_V(2); PG8_BAR;
    PG8_STAGE(PG8_SB(1, 0), cB + kstep, voffB); PG8_STAGE_A(PG8_SA(1, 0), cA + kstep, 0, voc); PG8_STAGE(PG8_SB(1, 1), cB + hstep + kstep, voffB);
    PG8_WAIT_V(6); PG8_BAR;
    for (;;) {
        const bool has_next = S.next(ui + 1, nxt);
        const char* nA = GATHER ? (const char*)g.A : (has_next ? (const char*)g.A + (size_t)nxt.pm * tstep : cA);
        const char* nB = has_next ? (const char*)g.Bt + (size_t)nxt.pn * tstep : cB;
        if constexpr (GATHER) { if (has_next) { PG8_GOFF(von, nxt); } else {
#pragma unroll
            for (int h = 0; h < 2; ++h)
#pragma unroll
                for (int i = 0; i < 2; ++i) von[h][i] = voc[h][i]; } }
#pragma unroll 1
        for (int t = 0; t < nt; t += 2) {
            const bool last = (t == nt - 2);
            const char* a1 = cA + (size_t)(t + 1) * kstep;
            const char* a2 = last ? nA : cA + (size_t)(t + 2) * kstep; const char* b2 = last ? nB : cB + (size_t)(t + 2) * kstep;
            const char* a3 = a2 + kstep; const char* b3 = b2 + kstep;
            unsigned vo2[2][2];
#pragma unroll
            for (int h = 0; h < 2; ++h)
#pragma unroll
                for (int i = 0; i < 2; ++i) { if constexpr (GATHER) vo2[h][i] = last ? von[h][i] : voc[h][i]; else vo2[h][i] = voffA[i]; }
            PG8_LDB(B0, 0, 0); PG8_LDB(B1, 0, 1); PG8_SCHED; PG8_LDA(At, 0, 0); PG8_STAGE_A(PG8_SA(1, 1), a1, 1, voc);
            PG8_WAIT_V(8); PG8_WAIT_L(0); PG8_BAR; PG8_MMA(0, 0, At, B0); PG8_MMA(0, 1, At, B1); PG8_BAR; PG8_SCHED;
            PG8_LDA(At, 0, 1); PG8_STAGE(PG8_SB(0, 0), b2, voffB); PG8_STAGE(PG8_SB(0, 1), b2 + hstep, voffB); PG8_STAGE_A(PG8_SA(0, 0), a2, 0, vo2);
            PG8_WAIT_V(8); PG8_WAIT_L(0); PG8_BAR; PG8_MMA(1, 0, At, B0); PG8_MMA(1, 1, At, B1); PG8_BAR; PG8_SCHED;
            PG8_LDB(B0, 1, 0); PG8_LDB(B1, 1, 1); PG8_SCHED; PG8_LDA(At, 1, 0); PG8_STAGE_A(PG8_SA(0, 1), a2, 1, vo2);
            PG8_WAIT_V(8); PG8_WAIT_L(0); PG8_BAR; PG8_MMA(0, 0, At, B0); PG8_MMA(0, 1, At, B1); PG8_BAR; PG8_SCHED;
            PG8_LDA(At, 1, 1); PG8_STAGE(PG8_SB(1, 0), b3, voffB); PG8_STAGE(PG8_SB(1, 1), b3 + hstep, voffB); PG8_STAGE_A(PG8_SA(1, 0), a3, 0, vo2);
            PG8_WAIT_V(8); PG8_WAIT_L(0); PG8_BAR; PG8_MMA(1, 0, At, B0); PG8_MMA(1, 1, At, B1); PG8_BAR; PG8_SCHED;
        }
        if constexpr (ALIGN_EPI) { if (wr == 0) PG8_BAR; }
        { int ln_ = lane; asm volatile("" : "+v"(ln_));
          if constexpr (FP8) asm volatile("s_nop 15\n\ts_nop 7" ::: "memory");
          E(acc, cur, wr, wc, ln_ & 15, ln_ >> 4); }
        if (!has_next) break;
#pragma unroll
        for (int a = 0; a < 2; ++a)
#pragma unroll
            for (int b = 0; b < 2; ++b)
#pragma unroll
                for (int m = 0; m < 4; ++m)
#pragma unroll
                    for (int n = 0; n < 2; ++n) acc[a][b][m][n] = (f32x4){0.f, 0.f, 0.f, 0.f};
        cur = nxt; cA = nA; cB = nB; ++ui;
        if constexpr (GATHER) {
#pragma unroll
            for (int h = 0; h < 2; ++h)
#pragma unroll
                for (int i = 0; i < 2; ++i) voc[h][i] = von[h][i]; }
        if constexpr (ALIGN_EPI) { if (wr == 1) PG8_BAR; }
    }
    PG8_WAIT_V(0);
    if constexpr (!ALIGN_EPI) { if (wr == 0) PG8_BAR; }
    PG8_BAR;
#undef PG8_SA
#undef PG8_SB
#undef PG8_STAGE
#undef PG8_STAGE_A
#undef PG8_LDA
#undef PG8_LDB
#undef PG8_MMA
#undef PG8_WAIT_V
#undef PG8_WAIT_L
#undef PG8_BAR
#undef PG8_SCHED
#undef PG8_GOFF
}
}

namespace attn_body {
using bf16=__hip_bfloat16;
using bf16x8=__attribute__((ext_vector_type(8)))short;
using s16x4=__attribute__((ext_vector_type(4)))short;
using f32x16=__attribute__((ext_vector_type(16)))float;
using u32x4=__attribute__((ext_vector_type(4)))unsigned;
using f32x4_t=__attribute__((ext_vector_type(4)))float;
constexpr int SEQ=2048,D=64,DM=1024;
constexpr int NW=8,QBLK=32,QB=QBLK*NW,KVBLK=64,NQB=SEQ/QB;
__device__ __forceinline__ int crow(int r,int hi){return (r&3)+8*(r>>2)+4*hi;}
#define SBAR() __builtin_amdgcn_sched_barrier(0)
__device__ __forceinline__ void cmask(f32x16&p0,f32x16&p1,int jb,int qrel,int hi){
  const float NEG=-INFINITY; int kb=64*jb+4*hi;
  #pragma unroll
  for(int r=0;r<16;++r){int kv=kb+(r&3)+8*(r>>2); if(kv>qrel)p0[r]=NEG; if(kv+32>qrel)p1[r]=NEG;}
}
constexpr int NSLOT=3, SLOTB=8192;
constexpr int LDS_K=0, LDS_V=NSLOT*SLOTB, LDS_WS=2*NSLOT*SLOTB, LDS_OST=LDS_WS+NW*64*4, LDS_BYTES=LDS_OST+NW*4096;
constexpr float C2=0.125f*1.4426950408889634f;
__device__ __forceinline__ void glds16(const void*gsrc,unsigned lds_dst){unsigned keep;
  asm volatile("s_mov_b32 %0, m0\n\ts_mov_b32 m0, %2\n\ts_nop 0\n\tglobal_load_lds_dwordx4 %1, off\n\ts_mov_b32 m0, %0":"=&s"(keep):"v"(gsrc),"s"(lds_dst):"memory");}
__device__ __forceinline__ float max3f(float a,float b,float c){float r;asm("v_max3_f32 %0, %1, %2, %3":"=v"(r):"v"(a),"v"(b),"v"(c));return r;}
__device__ __forceinline__ float max2f(float a,float b){float r;asm("v_max_f32_e32 %0, %1, %2":"=v"(r):"v"(a),"v"(b));return r;}
__device__ __forceinline__ float fadd_s(float a,float b){float r;asm("v_add_f32_e32 %0, %1, %2":"=v"(r):"v"(a),"v"(b));return r;}
__device__ __forceinline__ float fsub_s(float a,float b){float r;asm("v_sub_f32_e32 %0, %1, %2":"=v"(r):"v"(a),"v"(b));return r;}
typedef float f32x2_t __attribute__((ext_vector_type(2))); typedef __bf16 bf16x2_t __attribute__((ext_vector_type(2)));
__device__ __forceinline__ unsigned cvtpk_s(float lo,float hi){f32x2_t v={lo,hi};bf16x2_t b=__builtin_convertvector(v,bf16x2_t);return __builtin_bit_cast(unsigned,b);}
#define WAIT_BAR(N) asm volatile("s_waitcnt vmcnt(" #N ") lgkmcnt(0)\n\ts_barrier":::"memory")

__device__ __forceinline__ void qkt(f32x16&p0,f32x16&p1,const char*Kslot,const bf16x8*qr,const f32x16&negm,int r32,int hi){
  const char*kb=Kslot+hi*1024+r32*16;
  #pragma unroll
  for(int d0=0;d0<4;++d0){
    const bf16x8 b0=*reinterpret_cast<const bf16x8*>(kb+d0*2048);
    const bf16x8 b1=*reinterpret_cast<const bf16x8*>(kb+d0*2048+512);
    if(d0==0){p0=__builtin_amdgcn_mfma_f32_32x32x16_bf16(b0,qr[0],negm,0,0,0);p1=__builtin_amdgcn_mfma_f32_32x32x16_bf16(b1,qr[0],negm,0,0,0);}
    else{p0=__builtin_amdgcn_mfma_f32_32x32x16_bf16(b0,qr[d0],p0,0,0,0);p1=__builtin_amdgcn_mfma_f32_32x32x16_bf16(b1,qr[d0],p1,0,0,0);}}
}
typedef __attribute__((address_space(3))) const char* lds_cptr;
typedef short v4i16_t __attribute__((ext_vector_type(4)));
__device__ __forceinline__ void kload8(bf16x8*kf,lds_cptr kp){
  kf[0]=*(const __attribute__((address_space(3))) bf16x8*)(kp);      kf[1]=*(const __attribute__((address_space(3))) bf16x8*)(kp+512);
  kf[2]=*(const __attribute__((address_space(3))) bf16x8*)(kp+2048); kf[3]=*(const __attribute__((address_space(3))) bf16x8*)(kp+2560);
  kf[4]=*(const __attribute__((address_space(3))) bf16x8*)(kp+4096); kf[5]=*(const __attribute__((address_space(3))) bf16x8*)(kp+4608);
  kf[6]=*(const __attribute__((address_space(3))) bf16x8*)(kp+6144); kf[7]=*(const __attribute__((address_space(3))) bf16x8*)(kp+6656);
}
__device__ __forceinline__ void kload2(bf16x8*kf,lds_cptr kp,int j){ kf[2*j]=*(const __attribute__((address_space(3))) bf16x8*)(kp+j*2048); kf[2*j+1]=*(const __attribute__((address_space(3))) bf16x8*)(kp+j*2048+512); }
__device__ __forceinline__ s16x4 vtr(lds_cptr p){ return __builtin_bit_cast(s16x4,__builtin_amdgcn_ds_read_tr16_b64_v4i16((__attribute__((address_space(3))) v4i16_t*)p)); }
__device__ __forceinline__ float rowmax(const f32x16&p0,const f32x16&p1){
  float a=max3f(p0[0],p0[1],p1[0]),b=max3f(p0[2],p0[3],p1[1]);a=max3f(a,p1[2],p1[3]);
  #pragma unroll
  for(int r=4;r<16;r+=4){a=max3f(a,p0[r],p0[r+1]);b=max3f(b,p0[r+2],p0[r+3]);a=max3f(a,p1[r],p1[r+1]);b=max3f(b,p1[r+2],p1[r+3]);}
  const float m=max2f(a,b);
  auto rr=__builtin_amdgcn_permlane32_swap(__float_as_uint(m),__float_as_uint(m),false,false);
  return max2f(__uint_as_float(rr[0]),__uint_as_float(rr[1]));
}
constexpr int ATTN_LDS_BYTES=LDS_BYTES;
constexpr int V2_SLOTV=16384, V2_NSV=4, V2_LDS_K=0, V2_LDS_V=NSLOT*SLOTB, V2_LDS_WS=V2_LDS_V+V2_NSV*V2_SLOTV, V2_LDS_OST=V2_LDS_WS+NW*64*4, V2_LDS_BYTES=V2_LDS_OST+NW*4096;
template<int CTRL> __device__ __forceinline__ float dppf(float v){ return __builtin_bit_cast(float,__builtin_amdgcn_update_dpp(0,__builtin_bit_cast(int,v),CTRL,0xf,0xf,true)); }
struct PrimeNext { long rowbase; const bf16* K; const bf16* V; int on; };
__device__ __forceinline__ void attn_prime(long rowbase,const bf16*K,const bf16*V,char*shm){
  int tid_=threadIdx.x; asm volatile("":"+v"(tid_)::"memory");
  const int lane=tid_&63; const int wid=__builtin_amdgcn_readfirstlane(tid_>>6);
  const unsigned lds0=(unsigned)(uintptr_t)shm;
  const bf16*ksrc=K+rowbase*DM+(long)lane*DM+wid*8;
  const bf16*vsrc=V+rowbase*DM+(long)(16*(wid&3)+(lane>>2))*DM+(wid>>2)*32+(lane&3)*8;
  const unsigned kdst=lds0+V2_LDS_K+wid*1024, vdst=lds0+V2_LDS_V+wid*1024;
  glds16(ksrc,(unsigned)__builtin_amdgcn_readfirstlane(kdst));
  glds16(vsrc,(unsigned)__builtin_amdgcn_readfirstlane(vdst)); glds16(vsrc+64,(unsigned)__builtin_amdgcn_readfirstlane(vdst+8192));
  glds16(ksrc+(long)KVBLK*DM,(unsigned)__builtin_amdgcn_readfirstlane(kdst+SLOTB));
  glds16(ksrc+(long)2*KVBLK*DM,(unsigned)__builtin_amdgcn_readfirstlane(kdst+2*SLOTB));
  glds16(vsrc+(long)KVBLK*DM,(unsigned)__builtin_amdgcn_readfirstlane(vdst+V2_SLOTV)); glds16(vsrc+(long)KVBLK*DM+64,(unsigned)__builtin_amdgcn_readfirstlane(vdst+V2_SLOTV+8192));
  glds16(vsrc+(long)2*KVBLK*DM,(unsigned)__builtin_amdgcn_readfirstlane(vdst+2*V2_SLOTV)); glds16(vsrc+(long)2*KVBLK*DM+64,(unsigned)__builtin_amdgcn_readfirstlane(vdst+2*V2_SLOTV+8192));
}
template<int THRL> __device__ __forceinline__ void attn_pass2(long rowbase,int qb,const bf16*Q,const bf16*__restrict__ K,const bf16*__restrict__ V,char*shm,f32x16 (&o)[4],const PrimeNext nx){
  int tid_=threadIdx.x; asm volatile("":"+v"(tid_)::"memory");
  const int tid=tid_,lane=tid&63,r32=lane&31,hi=lane>>5; const int wid=__builtin_amdgcn_readfirstlane(tid>>6);
  const int q0=qb*QB;
  const bf16*Qw=Q+(rowbase+q0+wid*QBLK)*DM;
  const bf16*Kh=K+rowbase*DM,*Vh=V+rowbase*DM;
  const unsigned lds0=(unsigned)(uintptr_t)shm;
  float*wsf=(float*)(shm+V2_LDS_WS)+wid*64;
  const bf16*ksrc=Kh+(long)lane*DM+wid*8;
  const bf16*vsrc=Vh+(long)(16*(wid&3)+(lane>>2))*DM+(wid>>2)*32+(lane&3)*8;
  const unsigned kdst=lds0+V2_LDS_K+wid*1024, vdst=lds0+V2_LDS_V+wid*1024;
  #define DMA_K(t,slot) glds16(ksrc+(long)(t)*KVBLK*DM,(unsigned)__builtin_amdgcn_readfirstlane(kdst+(slot)))
  #define DMA_V(t,slot) do{ glds16(vsrc+(long)(t)*KVBLK*DM,(unsigned)__builtin_amdgcn_readfirstlane(vdst+(slot))); glds16(vsrc+(long)(t)*KVBLK*DM+64,(unsigned)__builtin_amdgcn_readfirstlane(vdst+(slot)+8192)); }while(0)
  const int vb0=(int)(lds0+V2_LDS_V)+((lane>>4)&1)*32+(lane&3)*8+(4*hi+((lane&15)>>2))*64;
  const char*Kbase=shm+V2_LDS_K; bf16x8 kf[8];
  const lds_cptr shm3=(lds_cptr)shm; const lds_cptr kp0=shm3+V2_LDS_K+hi*1024+r32*16; const lds_cptr vp0=shm3+V2_LDS_V+((lane>>4)&1)*32+(lane&3)*8+(4*hi+((lane&15)>>2))*64;
  const int NT=(q0+QB)/KVBLK;
  bf16x8 qr[4];
  #pragma unroll
  for(int d0=0;d0<4;++d0)qr[d0]=*reinterpret_cast<const bf16x8*>(&Qw[(long)r32*DM+d0*16+hi*8]);
  float mhat=0.f,l_reg=0.f; o[0]=f32x16{};o[1]=f32x16{};o[2]=f32x16{};o[3]=f32x16{};
  const f32x16 zero16=f32x16{}; f32x16 negm;
  const int qrel=wid*QBLK+r32;
  #define CMASK(P0,P1,t) do{int jb_=(t)-(NT-4); if(jb_>=0)cmask(P0,P1,jb_,qrel,hi);}while(0)
  bool resc=false;
  #define RESC() do{ if(resc){ asm volatile("s_waitcnt lgkmcnt(0)":::"memory"); \
      _Pragma("unroll") for(int d_=0;d_<4;++d_) _Pragma("unroll") for(int r=0;r<16;++r)o[d_][r]*=wsf[crow(r,hi)]; } }while(0)
  f32x16 C0,C1;
  u32x4 pw0,pw1,pw2,pw3;
  int sk_prev=0,sk_cur=0,sk_next=SLOTB, sv_prev=0,sv_cur=0,sv_tgt=2*V2_SLOTV;
  #define ROT() do{sk_prev=sk_cur;sk_cur=sk_next;sk_next=(sk_next==(NSLOT-1)*SLOTB)?0:sk_next+SLOTB; sv_prev=sv_cur;sv_cur=(sv_cur==(V2_NSV-1)*V2_SLOTV)?0:sv_cur+V2_SLOTV;sv_tgt=(sv_tgt==(V2_NSV-1)*V2_SLOTV)?0:sv_tgt+V2_SLOTV;}while(0)
  #define PKW(P,B) cvtpk_s(P[B],P[B+1])
  #define PAF(k) __builtin_bit_cast(bf16x8,pw##k)
  WAIT_BAR(0);
  { qkt(C0,C1,Kbase,qr,zero16,r32,hi); asm volatile("s_nop 15\n\ts_nop 7":"+v"(C0),"+v"(C1)); CMASK(C0,C1,0);
    const float rm=rowmax(C0,C1); mhat=rm; float sacc=0.f;
    _Pragma("unroll") for(int r=0;r<16;++r)negm[r]=-mhat; asm volatile("":"+v"(negm));
    _Pragma("unroll") for(int r=0;r<16;++r){C0[r]=__builtin_amdgcn_exp2f(C0[r]-mhat);C1[r]=__builtin_amdgcn_exp2f(C1[r]-mhat);sacc+=C0[r];sacc+=C1[r];}
    l_reg=sacc;
    pw0=(u32x4){PKW(C0,0),PKW(C0,2),PKW(C0,4),PKW(C0,6)};pw1=(u32x4){PKW(C0,8),PKW(C0,10),PKW(C0,12),PKW(C0,14)};pw2=(u32x4){PKW(C1,0),PKW(C1,2),PKW(C1,4),PKW(C1,6)};pw3=(u32x4){PKW(C1,8),PKW(C1,10),PKW(C1,12),PKW(C1,14)}; }
  WAIT_BAR(0);
  DMA_K(3,0);
  ROT();
  kload8(kf,kp0+sk_cur);
  WAIT_BAR(1);
  s16x4 vlo[4],vhi[4];
  #define VFR(i) (bf16x8){vlo[i][0],vlo[i][1],vlo[i][2],vlo[i][3],vhi[i][0],vhi[i][1],vhi[i][2],vhi[i][3]}
  #define PIN(x) asm volatile("":"+v"(x))
  #define MX3(a,b,c) __builtin_fmaxf(__builtin_fmaxf((a),(b)),(c))
  #define EXS(v) __builtin_amdgcn_exp2f((v)-mhat)
  #define GAPB(MF,XS,BS,XE,BE,XA,BA,EXTRA) do{ MF; XE[BE]=__builtin_amdgcn_exp2f(XE[BE]); XE[(BE)+1]=__builtin_amdgcn_exp2f(XE[(BE)+1]); \
      sacc0+=XA[BA]; sacc1+=XA[(BA)+1]; PIN(XE); PIN(sacc0); PIN(sacc1); EXTRA; SBAR(); }while(0)
  #define VRD(i,d,ks) do{ vlo[i]=vtr(vp_+((d)*4096+(ks)*1024)); vhi[i]=vtr(vp_+((d)*4096+(ks)*1024+512)); }while(0)
  #define KRD1(G,j) do{ if(G){ kf[j]=*(const __attribute__((address_space(3))) bf16x8*)(kp0+sk_next+((j)>>1)*2048+((j)&1)*512); SBAR(); } }while(0)
  #define QKG(MF) do{ MF; SBAR(); }while(0)
  #define STEP(t,GK,GV,GL) do{ SBAR(); \
    const lds_cptr vp_=vp0+sv_prev; \
    VRD(0,0,0); SBAR(); QKG(C0=__builtin_amdgcn_mfma_f32_32x32x16_bf16(kf[0],qr[0],negm,0,0,0)); \
    VRD(1,1,0); SBAR(); QKG(C1=__builtin_amdgcn_mfma_f32_32x32x16_bf16(kf[1],qr[0],negm,0,0,0)); \
    VRD(2,2,0); SBAR(); QKG(C0=__builtin_amdgcn_mfma_f32_32x32x16_bf16(kf[2],qr[1],C0,0,0,0)); \
    VRD(3,3,0); SBAR(); QKG(C1=__builtin_amdgcn_mfma_f32_32x32x16_bf16(kf[3],qr[1],C1,0,0,0)); \
    QKG(C0=__builtin_amdgcn_mfma_f32_32x32x16_bf16(kf[4],qr[2],C0,0,0,0)); \
    QKG(C1=__builtin_amdgcn_mfma_f32_32x32x16_bf16(kf[5],qr[2],C1,0,0,0)); \
    QKG(C0=__builtin_amdgcn_mfma_f32_32x32x16_bf16(kf[6],qr[3],C0,0,0,0)); \
    QKG(C1=__builtin_amdgcn_mfma_f32_32x32x16_bf16(kf[7],qr[3],C1,0,0,0)); \
    if(GK){DMA_K((t)+3,sk_cur);} if(GV){DMA_V((t)+2,sv_tgt);} \
    CMASK(C0,C1,t); \
    { float a=MX3(C0[0],C0[1],C1[0]),b=MX3(C0[2],C0[3],C1[1]); a=MX3(a,C1[2],C1[3]); \
      _Pragma("unroll") for(int r=4;r<16;r+=4){a=MX3(a,C0[r],C0[r+1]);b=MX3(b,C0[r+2],C0[r+3]);a=MX3(a,C1[r],C1[r+1]);b=MX3(b,C1[r+2],C1[r+3]);} \
      float rm=__builtin_fmaxf(a,b); { auto rr=__builtin_amdgcn_permlane32_swap(__float_as_uint(rm),__float_as_uint(rm),false,false); rm=__builtin_fmaxf(__uint_as_float(rr[0]),__uint_as_float(rr[1])); } \
      resc=false; \
      if(__builtin_expect(__any(rm>(float)THRL),0)){ const float dl=__builtin_fmaxf(rm,0.f); mhat+=dl; \
        _Pragma("unroll") for(int r=0;r<16;++r){C0[r]-=dl;C1[r]-=dl;} \
        _Pragma("unroll") for(int r=0;r<16;++r)negm[r]=-mhat; asm volatile("":"+v"(negm)); \
        const float f=__builtin_amdgcn_exp2f(-dl); l_reg*=f; if(hi==0)wsf[r32]=f; resc=true; } } \
    float sacc0=0.f,sacc1=0.f; \
    SBAR(); \
    { o[0]=__builtin_amdgcn_mfma_f32_32x32x16_bf16(PAF(0),VFR(0),o[0],0,0,0); C0[0]=__builtin_amdgcn_exp2f(C0[0]); C0[1]=__builtin_amdgcn_exp2f(C0[1]); PIN(C0); SBAR(); } VRD(0,0,1); SBAR(); \
    GAPB(o[1]=__builtin_amdgcn_mfma_f32_32x32x16_bf16(PAF(0),VFR(1),o[1],0,0,0), C0,4,  C0,2,  C0,0,  (void)0);  VRD(1,1,1); SBAR(); \
    GAPB(o[2]=__builtin_amdgcn_mfma_f32_32x32x16_bf16(PAF(0),VFR(2),o[2],0,0,0), C0,6,  C0,4,  C0,2,  (void)0);  VRD(2,2,1); SBAR(); \
    GAPB(o[3]=__builtin_amdgcn_mfma_f32_32x32x16_bf16(PAF(0),VFR(3),o[3],0,0,0), C0,8,  C0,6,  C0,4,  (void)0);  VRD(3,3,1); SBAR(); \
    GAPB(o[0]=__builtin_amdgcn_mfma_f32_32x32x16_bf16(PAF(1),VFR(0),o[0],0,0,0), C0,10, C0,8,  C0,6,  pw0[0]=PKW(C0,0); pw0[1]=PKW(C0,2); PIN(pw0));  VRD(0,0,2); SBAR(); \
    GAPB(o[1]=__builtin_amdgcn_mfma_f32_32x32x16_bf16(PAF(1),VFR(1),o[1],0,0,0), C0,12, C0,10, C0,8,  pw0[2]=PKW(C0,4); pw0[3]=PKW(C0,6); PIN(pw0));  VRD(1,1,2); SBAR(); \
    GAPB(o[2]=__builtin_amdgcn_mfma_f32_32x32x16_bf16(PAF(1),VFR(2),o[2],0,0,0), C0,14, C0,12, C0,10, (void)0); VRD(2,2,2); SBAR(); \
    GAPB(o[3]=__builtin_amdgcn_mfma_f32_32x32x16_bf16(PAF(1),VFR(3),o[3],0,0,0), C1,0,  C0,14, C0,12, (void)0); VRD(3,3,2); SBAR(); \
    KRD1(GL,0); GAPB(o[0]=__builtin_amdgcn_mfma_f32_32x32x16_bf16(PAF(2),VFR(0),o[0],0,0,0), C1,2,  C1,0,  C0,14, pw1[0]=PKW(C0,8);  pw1[1]=PKW(C0,10); PIN(pw1));  VRD(0,0,3); SBAR(); \
    KRD1(GL,1); GAPB(o[1]=__builtin_amdgcn_mfma_f32_32x32x16_bf16(PAF(2),VFR(1),o[1],0,0,0), C1,4,  C1,2,  C1,0,  pw1[2]=PKW(C0,12); pw1[3]=PKW(C0,14); PIN(pw1));  VRD(1,1,3); SBAR(); \
    KRD1(GL,2); GAPB(o[2]=__builtin_amdgcn_mfma_f32_32x32x16_bf16(PAF(2),VFR(2),o[2],0,0,0), C1,6,  C1,4,  C1,2,  (void)0);  VRD(2,2,3); SBAR(); \
    KRD1(GL,3); GAPB(o[3]=__builtin_amdgcn_mfma_f32_32x32x16_bf16(PAF(2),VFR(3),o[3],0,0,0), C1,8,  C1,6,  C1,4,  (void)0);  VRD(3,3,3); SBAR(); \
    KRD1(GL,4); GAPB(o[0]=__builtin_amdgcn_mfma_f32_32x32x16_bf16(PAF(3),VFR(0),o[0],0,0,0), C1,10, C1,8,  C1,6,  pw2[0]=PKW(C1,0); pw2[1]=PKW(C1,2); PIN(pw2)); \
    KRD1(GL,5); GAPB(o[1]=__builtin_amdgcn_mfma_f32_32x32x16_bf16(PAF(3),VFR(1),o[1],0,0,0), C1,12, C1,10, C1,8,  pw2[2]=PKW(C1,4); pw2[3]=PKW(C1,6); PIN(pw2)); \
    KRD1(GL,6); GAPB(o[2]=__builtin_amdgcn_mfma_f32_32x32x16_bf16(PAF(3),VFR(2),o[2],0,0,0), C1,14, C1,12, C1,10, (void)0); \
    KRD1(GL,7); { o[3]=__builtin_amdgcn_mfma_f32_32x32x16_bf16(PAF(3),VFR(3),o[3],0,0,0); C1[14]=__builtin_amdgcn_exp2f(C1[14]); C1[15]=__builtin_amdgcn_exp2f(C1[15]); sacc0+=C1[12]; sacc1+=C1[13]; PIN(C1); PIN(sacc0); PIN(sacc1); \
      pw3[0]=PKW(C1,8); pw3[1]=PKW(C1,10); pw3[2]=PKW(C1,12); PIN(pw3); SBAR(); } \
    pw3[3]=PKW(C1,14); sacc0+=C1[14]; sacc1+=C1[15]; \
    l_reg+=sacc0+sacc1; \
    }while(0)
  int t=1;
  #undef CMASK
  #define CMASK(P0,P1,t) do{}while(0)
  #define ENDW(tt) do{ const int n_=((tt)+2>=NT)?0:((((tt)>1)?2:0)+(((tt)+3<NT)?1:0)+(((tt)+2<NT)?2:0)); \
      if(n_==5){WAIT_BAR(5);} else if(n_==4){WAIT_BAR(4);} else if(n_==3){WAIT_BAR(3);} else if(n_==2){WAIT_BAR(2);} else {WAIT_BAR(0);} }while(0)
  for(;t+4<NT;++t){ STEP(t,true,true,true); if(t==1){WAIT_BAR(3);} else {WAIT_BAR(5);} RESC(); ROT(); }
  #undef CMASK
  #define CMASK(P0,P1,t) do{int jb_=(t)-(NT-4); if(jb_>=0)cmask(P0,P1,jb_,qrel,hi);}while(0)
  for(;t+1<NT;++t){ STEP(t,(t+3<NT),(t+2<NT),(t+1<NT)); ENDW(t); RESC(); ROT(); }
  STEP(NT-1,false,false,false); RESC();
  { SBAR(); const int vb=vb0+sv_cur;
    #pragma unroll
    for(int d0=0;d0<4;++d0){s16x4 lo[4],hh[4];
      #pragma unroll
      for(int ks=0;ks<4;++ks){
        asm volatile("ds_read_b64_tr_b16 %0,%1 offset:%c2":"=&v"(lo[ks]):"v"(vb),"i"(d0*4096+ks*1024):"memory");
        asm volatile("ds_read_b64_tr_b16 %0,%1 offset:%c2":"=&v"(hh[ks]):"v"(vb),"i"(d0*4096+ks*1024+512):"memory");}
      asm volatile("s_waitcnt lgkmcnt(0)":::"memory");SBAR();
      #define PK(k) (bf16x8){lo[k][0],lo[k][1],lo[k][2],lo[k][3],hh[k][0],hh[k][1],hh[k][2],hh[k][3]}
      o[d0]=__builtin_amdgcn_mfma_f32_32x32x16_bf16(PAF(0),PK(0),o[d0],0,0,0);
      o[d0]=__builtin_amdgcn_mfma_f32_32x32x16_bf16(PAF(1),PK(1),o[d0],0,0,0);
      o[d0]=__builtin_amdgcn_mfma_f32_32x32x16_bf16(PAF(2),PK(2),o[d0],0,0,0);
      o[d0]=__builtin_amdgcn_mfma_f32_32x32x16_bf16(PAF(3),PK(3),o[d0],0,0,0);
      #undef PK
    } }
  #undef PKW
  #undef PAF
  #undef VFR
  #undef PIN
  #undef MX3
  #undef GAPB
  #undef EXS
  #undef VRD
  #undef KRD1
  #undef QKG
  #undef STEP
  #undef ENDW
  asm volatile("s_waitcnt lgkmcnt(0)\n\ts_barrier":::"memory");
  if(nx.on)attn_prime(nx.rowbase,nx.K,nx.V,shm);
  {auto rr=__builtin_amdgcn_permlane32_swap(__float_as_uint(l_reg),__float_as_uint(l_reg),false,false);l_reg=__uint_as_float(rr[0])+__uint_as_float(rr[1]);}
  if(hi==0)wsf[32+r32]=l_reg;asm volatile("s_waitcnt lgkmcnt(0)":::"memory");
  #pragma unroll
  for(int r=0;r<16;++r){ const float rl=__builtin_amdgcn_rcpf(wsf[32+crow(r,hi)]);
    #pragma unroll
    for(int d0=0;d0<4;++d0)o[d0][r]*=rl; }
  #undef DMA_K
  #undef DMA_V
  #undef CMASK
  #undef RESC
  #undef ROT
}
__device__ __forceinline__ void diff_attn_unit(long rowbase,int qb,const bf16*Q1,const bf16*K1,const bf16*Q2,const bf16*K2,const bf16*V,bf16*ON,float*blob,float lam,const float*swp,float sws,char*shm,const PrimeNext nx){
  f32x16 o[4];
  attn_pass2<8>(rowbase,qb,Q1,K1,V,shm,o,PrimeNext{rowbase,K2,V,1});
  { int ln_=threadIdx.x; asm volatile("":"+v"(ln_)::"memory"); const int lane=ln_&63; float*bp=blob+lane*4;
    #pragma unroll
    for(int d0=0;d0<4;++d0)
      #pragma unroll
      for(int g=0;g<2;++g){ u32x4 w; w.x=cvtpk_s(o[d0][8*g],o[d0][8*g+1]); w.y=cvtpk_s(o[d0][8*g+2],o[d0][8*g+3]); w.z=cvtpk_s(o[d0][8*g+4],o[d0][8*g+5]); w.w=cvtpk_s(o[d0][8*g+6],o[d0][8*g+7]);
        __builtin_nontemporal_store(w,(u32x4*)(bp+(d0*2+g)*256)); } }
  attn_pass2<8>(rowbase,qb,Q2,K2,V,shm,o,nx);
  int tid_=threadIdx.x; asm volatile("":"+v"(tid_)::"memory");
  const int tid=tid_,lane=tid&63,r32=lane&31,hi=lane>>5; const int wid=__builtin_amdgcn_readfirstlane(tid>>6);
  asm volatile("":::"memory");
  { const float*bp=blob+lane*4;
    #pragma unroll
    for(int d0=0;d0<4;++d0)
      #pragma unroll
      for(int g=0;g<2;++g){ const u32x4 w=__builtin_nontemporal_load((const u32x4*)(bp+(d0*2+g)*256));
        const float a0=__uint_as_float(w.x<<16),a1=__uint_as_float(w.x&0xffff0000u),a2=__uint_as_float(w.y<<16),a3=__uint_as_float(w.y&0xffff0000u),a4=__uint_as_float(w.z<<16),a5=__uint_as_float(w.z&0xffff0000u),a6=__uint_as_float(w.w<<16),a7=__uint_as_float(w.w&0xffff0000u);
        o[d0][8*g]=a0-lam*o[d0][8*g]; o[d0][8*g+1]=a1-lam*o[d0][8*g+1]; o[d0][8*g+2]=a2-lam*o[d0][8*g+2]; o[d0][8*g+3]=a3-lam*o[d0][8*g+3];
        o[d0][8*g+4]=a4-lam*o[d0][8*g+4]; o[d0][8*g+5]=a5-lam*o[d0][8*g+5]; o[d0][8*g+6]=a6-lam*o[d0][8*g+6]; o[d0][8*g+7]=a7-lam*o[d0][8*g+7]; } }
  float rs[16];
  #pragma unroll
  for(int r=0;r<16;++r){ float ss=(o[0][r]*o[0][r]+o[1][r]*o[1][r])+(o[2][r]*o[2][r]+o[3][r]*o[3][r]);
    ss+=dppf<0xB1>(ss); ss+=dppf<0x4E>(ss); ss+=dppf<0x141>(ss); ss+=dppf<0x140>(ss);
    { auto rr=__builtin_amdgcn_permlane16_swap(__float_as_uint(ss),__float_as_uint(ss),false,false); ss=__uint_as_float(rr[0])+__uint_as_float(rr[1]); }
    rs[r]=1.f/sqrtf(ss*(1.f/128.f)+1e-5f); }
  const float sw0=swp[r32]*sws,sw1=swp[32+r32]*sws,sw2=swp[64+r32]*sws,sw3=swp[96+r32]*sws;
  bf16*Ow=ON+(rowbase+qb*QB+wid*QBLK)*DM;
  bf16*stg=(bf16*)(shm+V2_LDS_OST)+wid*2048;
  #pragma unroll
  for(int rd=0;rd<2;++rd){
    #pragma unroll
    for(int r=0;r<16;++r){const int orow=crow(r,hi);
      stg[orow*64+r32]=__float2bfloat16(o[2*rd][r]*rs[r]*(rd?sw2:sw0));
      stg[orow*64+32+r32]=__float2bfloat16(o[2*rd+1][r]*rs[r]*(rd?sw3:sw1)); }
    asm volatile("s_waitcnt lgkmcnt(0)":::"memory");
    #pragma unroll
    for(int i=0;i<4;++i){const int row=i*8+(lane>>3),ch=lane&7; const u32x4 v=*(const u32x4*)(stg+row*64+ch*8); *(u32x4*)(Ow+(long)row*DM+rd*64+ch*8)=v;}
    asm volatile("s_waitcnt lgkmcnt(0)":::"memory"); }
  asm volatile("s_waitcnt vmcnt(0) lgkmcnt(0)\n\ts_barrier":::"memory");
}
constexpr int ATTN2_LDS_BYTES=V2_LDS_BYTES;
#undef SBAR
#undef WAIT_BAR
}

constexpr int NWAVES = 8, NTHR = NWAVES * 64;
constexpr int BATCH = 16, SEQ = 2048, DMODEL = 1024, TOK = BATCH * SEQ;
constexpr int GATE0 = 3584, GATEW = 2048;
constexpr int POOLW = 512, INW = 5632, NEXP = 32, TOPK = 4, NLAYER = 2;
constexpr int CAP = TOK;
constexpr int MAXROWS = TOK * TOPK + NEXP * 256;
constexpr float LN_EPS = 1e-5f, ALPHA = 1.41421356237309515f;
constexpr float SW_ALPHA = 1.702f, SW_LIMIT = 7.0f;

constexpr size_t MiB = 1u << 20;
constexpr size_t WS_CTL = 0, CTL_ZERO_BYTES = 64 * 1024;
constexpr size_t WS_CS    = 1 * MiB;
constexpr size_t WS_TOKE  = 3 * MiB;
constexpr size_t WS_TOKG  = WS_TOKE + MiB / 2;
constexpr size_t WS_RTOK  = 4 * MiB;
constexpr size_t WS_WRT   = 8 * MiB;
constexpr size_t WS_WIN   = 9 * MiB;
constexpr size_t WS_WPF   = 31 * MiB;
constexpr size_t WS_WAB   = 33 * MiB;
constexpr size_t WS_WOUT  = 37 * MiB;
constexpr size_t WS_WGU   = 41 * MiB;
constexpr size_t WS_WD    = 297 * MiB;
constexpr size_t WS_XB    = 425 * MiB;
constexpr size_t WS_PROJ  = 489 * MiB;
constexpr size_t WS_U = WS_PROJ, WS_Q = WS_U + 32 * MiB, WS_K = WS_Q + 64 * MiB, WS_V = WS_K + 64 * MiB, WS_G = WS_V + 64 * MiB;
constexpr size_t WS_ACT   = 1705 * MiB;
constexpr size_t WS_DP    = 841 * MiB;
constexpr size_t WS_ATT   = 873 * MiB;
constexpr size_t WS_O1 = WS_ATT, WS_O2 = WS_O1 + 64 * MiB, WS_ON = WS_O2 + 64 * MiB, WS_YPG = WS_ON + 64 * MiB;
constexpr size_t WS_YS    = WS_ATT;
constexpr size_t WS_MRG   = 1193 * MiB;
constexpr size_t WS_Y     = 1257 * MiB;
constexpr size_t WS_X1    = 1385 * MiB;
constexpr size_t WS_X1B   = 1513 * MiB;
constexpr size_t WS_X2    = 1577 * MiB;
constexpr size_t WS_XB8   = WS_X2;
constexpr size_t WS_WIN8  = WS_X2 + 64 * MiB;
constexpr size_t WS_END   = 1841 * MiB;
static_assert((size_t)MAXROWS * 1024 * 2 <= 352 * MiB && (size_t)MAXROWS * 1024 * 2 <= 320 * MiB, "overlays");
constexpr int CW_CURSOR = 8192;
constexpr size_t WS_STATS = 1385 * MiB;
constexpr int CW_BAR = 4096;
static_assert((CW_CURSOR + NLAYER * 32 * 64) * 4 <= (int)CTL_ZERO_BYTES && (CW_BAR + 3456) <= CW_CURSOR, "control words inside the per-call memset");

constexpr int RING_OFF = 0, RING_BYTES = 139264;
constexpr int MISC_OFF = RING_BYTES;
constexpr int LDS_BYTES = 147456;
constexpr int TAB_CNT = 16, TAB_BLK = 48, TAB_RB = 96;
static_assert(TAB_RB - TAB_BLK == pg8::TAB_RB_REL, "rb table offset");

#define GAS __attribute__((address_space(1)))
#define LAS __attribute__((address_space(3)))
typedef unsigned short bf16;
typedef unsigned v4u __attribute__((ext_vector_type(4)));
typedef unsigned v2u __attribute__((ext_vector_type(2)));
typedef float f32x4 __attribute__((ext_vector_type(4)));
typedef float f32x2 __attribute__((ext_vector_type(2)));
typedef GAS unsigned gu32;
#define RLX_AGENT __ATOMIC_RELAXED, __HIP_MEMORY_SCOPE_AGENT
#define LDS_WAIT() asm volatile("s_waitcnt lgkmcnt(0)" ::: "memory")
#define VM_WAIT() asm volatile("s_waitcnt vmcnt(0)" ::: "memory")
__device__ __forceinline__ unsigned f2bf(float f) { unsigned u = __builtin_bit_cast(unsigned, f); return (u + 0x7fffu + ((u >> 16) & 1u)) >> 16; }
__device__ __forceinline__ unsigned pk2(float lo, float hi) { return pg8::cvt_pk_bf16(lo, hi); }
using pg8::bf_lo; using pg8::bf_hi;

#define XB_TMO      128
#define XB_XCNT(j)  (256  + 64 * (j))
#define XB_XSUB(j)  (1280 + 64 * (j))
#define XB_XGEN(j)  (2304 + 64 * (j))
#define XB_TOP      3328
#define XB_TOPGEN   3392
#define XCD_BAR_WORDS 3456
#define XB_SPIN_CAP (1u << 18)

__device__ __forceinline__ unsigned xb_ld(unsigned* p)              { return __hip_atomic_load(p, __ATOMIC_RELAXED, __HIP_MEMORY_SCOPE_AGENT); }
__device__ __forceinline__ unsigned xb_add(unsigned* p, unsigned v) { return __hip_atomic_fetch_add(p, v, __ATOMIC_RELAXED, __HIP_MEMORY_SCOPE_AGENT); }
__device__ __forceinline__ unsigned xb_xcc_id() { return (unsigned)__builtin_amdgcn_s_getreg((3 << 11) | 20) & 0xFu; }
#define XB_SPIN(cond, bar) do { unsigned _sp = 0; while (cond) { __builtin_amdgcn_s_sleep(1); \
    if ((++_sp & 255u) == 0u) { if (xb_ld(&(bar)[XB_TMO])) break; if (_sp > XB_SPIN_CAP) { atomicAdd(&(bar)[XB_TMO], 1u); break; } } } } while (0)

struct XcdBarrier {
    unsigned* bar; unsigned x;
    volatile LAS unsigned* st;
};
__device__ __forceinline__ XcdBarrier xcd_barrier_post(unsigned* bar, volatile LAS unsigned* st) {
    XcdBarrier b; b.bar = bar; b.x = xb_xcc_id(); b.st = st;
    if (threadIdx.x == 0) (void)xb_add(&bar[XB_XCNT(b.x)], 1u);
    return b;
}
__device__ __forceinline__ void xcd_barrier_complete(unsigned* bar, unsigned x, unsigned& nloc, unsigned& nx) {
    const unsigned G = gridDim.x * gridDim.y * gridDim.z;
    unsigned sum, cnt, mine, sp = 0u;
    for (;;) {
        sum = 0u; cnt = 0u; mine = 0u;
#pragma unroll
        for (unsigned j = 0; j < 16; ++j) { const unsigned c = xb_ld(&bar[XB_XCNT(j)]); sum += c; cnt += (c > 0u) ? 1u : 0u; mine = (j == x) ? c : mine; }
        if (sum == G) break;
        __builtin_amdgcn_s_sleep(1);
        if ((++sp & 255u) == 0u) { if (xb_ld(&bar[XB_TMO])) break; if (sp > XB_SPIN_CAP) { atomicAdd(&bar[XB_TMO], 1u); break; } }
    }
    nloc = mine > 0u ? mine : 1u; nx = cnt > 0u ? cnt : 1u;
}
__device__ __forceinline__ void xcd_barrier(const XcdBarrier& b) {
    asm volatile("s_waitcnt vmcnt(0)" ::: "memory");
    __syncthreads();
    if (threadIdx.x == 0) {
        unsigned* bar = b.bar;
        __builtin_amdgcn_s_waitcnt(0);
        unsigned nloc = b.st[0], nx = b.st[1];
        if (nloc == 0u) { xcd_barrier_complete(bar, b.x, nloc, nx); b.st[0] = nloc; b.st[1] = nx; }
        const unsigned old = xb_add(&bar[XB_XSUB(b.x)], 1u);
        const unsigned gen = old / nloc;
        if (old + 1u == (gen + 1u) * nloc) {
            __builtin_amdgcn_fence(__ATOMIC_RELEASE, "agent");
            asm volatile("s_waitcnt vmcnt(0)" ::: "memory");
            const unsigned og = xb_add(&bar[XB_TOP], 1u);
            const unsigned tg = og / nx;
            if (og + 1u == (tg + 1u) * nx) xb_add(&bar[XB_TOPGEN], 1u);
            else XB_SPIN(xb_ld(&bar[XB_TOPGEN]) == tg, bar);
            __builtin_amdgcn_fence(__ATOMIC_ACQUIRE, "agent");
            xb_add(&bar[XB_XGEN(b.x)], 1u);
            asm volatile("s_waitcnt vmcnt(0)" ::: "memory");
        } else {
            XB_SPIN(xb_ld(&bar[XB_XGEN(b.x)]) == gen, bar);
            __builtin_amdgcn_fence(__ATOMIC_ACQUIRE, "agent");
            asm volatile("s_waitcnt vmcnt(0)" ::: "memory");
        }
    }
    __syncthreads();
}

struct Frame {
    LAS unsigned char* lds;
    volatile LAS unsigned* MISC;
    gu32* ctl;
    unsigned char* ws;
    int tid, lane, wave;
    int vcu, G;
};

template <int CTRL> __device__ __forceinline__ float dpp_f(float v) { return __builtin_bit_cast(float, __builtin_amdgcn_update_dpp(0, __builtin_bit_cast(int, v), CTRL, 0xf, 0xf, true)); }
template <int CTRL> __device__ __forceinline__ unsigned dpp_u(unsigned v) { return (unsigned)__builtin_amdgcn_update_dpp(0, (int)v, CTRL, 0xf, 0xf, true); }
__device__ __forceinline__ float swap16_add(float a, float b) { auto r = __builtin_amdgcn_permlane16_swap(__float_as_uint(a), __float_as_uint(b), false, false); return __uint_as_float(r[0]) + __uint_as_float(r[1]); }
__device__ __forceinline__ float swap32_add(float a, float b) { auto r = __builtin_amdgcn_permlane32_swap(__float_as_uint(a), __float_as_uint(b), false, false); return __uint_as_float(r[0]) + __uint_as_float(r[1]); }
__device__ __forceinline__ float wave_sum(float v) {
    v += dpp_f<0xB1>(v); v += dpp_f<0x4E>(v); v += dpp_f<0x141>(v); v += dpp_f<0x140>(v);
    v = swap16_add(v, v); v = swap32_add(v, v);
    return v;
}

constexpr int TAB_UNITS = 1024;
__device__ __forceinline__ pg8::TableOrder unit_table(Frame& F, const pg8::StaticOrder& S) {
    __syncthreads();
    if (F.tid < 32) { pg8::Unit u; const bool ok = S.next(F.tid, u); if (ok) { F.MISC[TAB_UNITS + F.tid * 8] = (unsigned)u.pm; F.MISC[TAB_UNITS + F.tid * 8 + 1] = (unsigned)u.pn; }
        const unsigned long long m = __ballot(ok); if (F.tid == 0) F.MISC[TAB_UNITS - 1] = (unsigned)__popcll(m); }
    __syncthreads();
    return pg8::TableOrder{(const LAS int*)(F.lds + MISC_OFF) + TAB_UNITS, (int)F.MISC[TAB_UNITS - 1]};
}

namespace pg8 {
struct EpiInProj {
    static constexpr bool PERM = true;
    bf16_t *U, *Q, *Kb, *V, *Gt; const float* cs; int pn0; float ds;
    __device__ __forceinline__ void operator()(const f32x4 (&acc)[2][2][4][2], const Unit& u, int wr, int wc, int fr, int fq) const {
        const int pn = u.pn + pn0; bf16_t* base; int ldc, colt, mode;
        if (pn < 2) { base = U; ldc = 512; colt = pn * 256; mode = 0; }
        else if (pn < 6) { base = Q; ldc = 1024; colt = (pn - 2) * 256; mode = 1; }
        else if (pn < 10) { base = Kb; ldc = 1024; colt = (pn - 6) * 256; mode = 2; }
        else if (pn < 14) { base = V; ldc = 1024; colt = (pn - 10) * 256; mode = 0; }
        else { base = Gt; ldc = 2048; colt = (pn - 14) * 256; mode = 3; }
        const int row0 = u.pm * BM + wr * 64 + fr, col0 = colt + wc * 32 + 8 * fq;
        const bool rot = (mode == 1 || mode == 2) && ((wc & 1) == 0);
        const float sgn = (fq == 0) ? -1.f : 1.f; const bool act = fq < 2;
        const float sc = (mode == 1) ? attn_body::C2 : 1.f;
#pragma unroll
        for (int ai = 0; ai < 2; ++ai)
#pragma unroll
            for (int m = 0; m < 4; ++m) { const int row = row0 + ai * HALF + m * 16; bf16_t* rowp = base + (size_t)row * ldc + col0;
                f32x4 c0 = {1.f, 1.f, 1.f, 1.f}, c1 = c0, s0 = {0.f, 0.f, 0.f, 0.f}, s1 = s0;
                if (rot) { const f32x4* t = (const f32x4*)(cs + (size_t)row * 16); c0 = t[0]; c1 = t[1]; s0 = t[2]; s1 = t[3]; }
#pragma unroll
                for (int bj = 0; bj < 2; ++bj) { f32x4 v0 = acc[ai][bj][m][0], v1 = acc[ai][bj][m][1];
                    if (rot) { f32x4 p0, p1;
#pragma unroll
                        for (int i = 0; i < 4; ++i) { auto r0 = __builtin_amdgcn_permlane16_swap(__float_as_uint(v0[i]), __float_as_uint(v0[i]), false, false); p0[i] = __uint_as_float((fq & 1) ? r0[0] : r0[1]);
                            auto r1 = __builtin_amdgcn_permlane16_swap(__float_as_uint(v1[i]), __float_as_uint(v1[i]), false, false); p1[i] = __uint_as_float((fq & 1) ? r1[0] : r1[1]); }
                        if (act) { v0 = v0 * c0 + (p0 * s0) * sgn; v1 = v1 * c1 + (p1 * s1) * sgn; } }
                    if (mode == 3) { const f32x4 z0 = v0 * (-1.4426950408889634f * ds), z1 = v1 * (-1.4426950408889634f * ds); f32x4 e0, e1;
#pragma unroll
                        for (int i = 0; i < 4; ++i) { e0[i] = __builtin_amdgcn_exp2f(z0[i]); e1[i] = __builtin_amdgcn_exp2f(z1[i]); }
                        e0 = e0 + 1.f; e1 = e1 + 1.f;
#pragma unroll
                        for (int i = 0; i < 4; ++i) { v0[i] = __builtin_amdgcn_rcpf(e0[i]); v1[i] = __builtin_amdgcn_rcpf(e1[i]); } }
                    v0 = v0 * sc; v1 = v1 * sc;
                    u32x4 w; w.x = cvt_pk_bf16(v0[0], v0[1]); w.y = cvt_pk_bf16(v0[2], v0[3]); w.z = cvt_pk_bf16(v1[0], v1[1]); w.w = cvt_pk_bf16(v1[2], v1[3]);
                    *(u32x4*)(rowp + bj * HALF) = w; } }
    }
};
struct EpiGate0 {
    static constexpr bool PERM = true;
    bf16_t* MRG; const bf16_t* Gt;
    __device__ __forceinline__ void operator()(const f32x4 (&acc)[2][2][4][2], const Unit& u, int wr, int wc, int fr, int fq) const {
        const int row0 = u.pm * BM + wr * 64 + fr, col0 = u.pn * BM + wc * 32 + 8 * fq;
#pragma unroll
        for (int ai = 0; ai < 2; ++ai) { u32x4 gw[4][2];
#pragma unroll
            for (int m = 0; m < 4; ++m)
#pragma unroll
                for (int bj = 0; bj < 2; ++bj) gw[m][bj] = *(const u32x4*)(Gt + (size_t)(row0 + ai * HALF + m * 16) * 2048 + col0 + bj * HALF);
#pragma unroll
            for (int m = 0; m < 4; ++m) { const int row = row0 + ai * HALF + m * 16;
#pragma unroll
                for (int bj = 0; bj < 2; ++bj) { const int col = col0 + bj * HALF; const u32x4 g = gw[m][bj];
                    f32x4 v0 = acc[ai][bj][m][0], v1 = acc[ai][bj][m][1];
                    v0[0] *= bf_lo(g.x); v0[1] *= bf_hi(g.x); v0[2] *= bf_lo(g.y); v0[3] *= bf_hi(g.y);
                    v1[0] *= bf_lo(g.z); v1[1] *= bf_hi(g.z); v1[2] *= bf_lo(g.w); v1[3] *= bf_hi(g.w);
                    u32x4 w; w.x = cvt_pk_bf16(v0[0], v0[1]); w.y = cvt_pk_bf16(v0[2], v0[3]); w.z = cvt_pk_bf16(v1[0], v1[1]); w.w = cvt_pk_bf16(v1[2], v1[3]);
                    *(u32x4*)(MRG + (size_t)row * 1024 + col) = w; } }
            asm volatile("" ::: "memory"); }
    }
};
struct EpiGate1 {
    static constexpr bool PERM = true;
    const bf16_t* Gt; bf16_t* MRG;
    __device__ __forceinline__ void operator()(const f32x4 (&acc)[2][2][4][2], const Unit& u, int wr, int wc, int fr, int fq) const {
        const int row0 = u.pm * BM + wr * 64 + fr, col0 = u.pn * BM + wc * 32 + 8 * fq;
#pragma unroll
        for (int ai = 0; ai < 2; ++ai) { u32x4 gw[4][2], yw[4][2];
#pragma unroll
            for (int m = 0; m < 4; ++m)
#pragma unroll
                for (int bj = 0; bj < 2; ++bj) { gw[m][bj] = *(const u32x4*)(Gt + (size_t)(row0 + ai * HALF + m * 16) * 2048 + 1024 + col0 + bj * HALF);
                    yw[m][bj] = *(const u32x4*)(MRG + (size_t)(row0 + ai * HALF + m * 16) * 1024 + col0 + bj * HALF); }
#pragma unroll
            for (int m = 0; m < 4; ++m) { const int row = row0 + ai * HALF + m * 16;
#pragma unroll
                for (int bj = 0; bj < 2; ++bj) { const int col = col0 + bj * HALF; const u32x4 g = gw[m][bj], y = yw[m][bj];
                    f32x4 v0 = acc[ai][bj][m][0], v1 = acc[ai][bj][m][1];
                    v0[0] = bf_lo(y.x) + v0[0] * bf_lo(g.x); v0[1] = bf_hi(y.x) + v0[1] * bf_hi(g.x); v0[2] = bf_lo(y.y) + v0[2] * bf_lo(g.y); v0[3] = bf_hi(y.y) + v0[3] * bf_hi(g.y);
                    v1[0] = bf_lo(y.z) + v1[0] * bf_lo(g.z); v1[1] = bf_hi(y.z) + v1[1] * bf_hi(g.z); v1[2] = bf_lo(y.w) + v1[2] * bf_lo(g.w); v1[3] = bf_hi(y.w) + v1[3] * bf_hi(g.w);
                    u32x4 w; w.x = cvt_pk_bf16(v0[0], v0[1]); w.y = cvt_pk_bf16(v0[2], v0[3]); w.z = cvt_pk_bf16(v1[0], v1[1]); w.w = cvt_pk_bf16(v1[2], v1[3]);
                    *(u32x4*)(MRG + (size_t)row * 1024 + col) = w; } }
            asm volatile("" ::: "memory"); }
    }
};
struct EpiOut {
    static constexpr bool PERM = true;
    const float* Xf; const bf16_t* Xb; bf16_t* Y; float* ST;
    __device__ __forceinline__ void operator()(const f32x4 (&acc)[2][2][4][2], const Unit& u, int wr, int wc, int fr, int fq) const {
        const int row0 = u.pm * BM + wr * 64 + fr, col0 = u.pn * BM + wc * 32 + 8 * fq;
#pragma unroll
        for (int ai = 0; ai < 2; ++ai) { f32x4 xs[4][2][2];
            if (Xf) {
#pragma unroll
                for (int m = 0; m < 4; ++m)
#pragma unroll
                    for (int bj = 0; bj < 2; ++bj) { const float* p = Xf + (size_t)(row0 + ai * HALF + m * 16) * 1024 + col0 + bj * HALF; xs[m][bj][0] = *(const f32x4*)p; xs[m][bj][1] = *(const f32x4*)(p + 4); }
            } else { u32x4 xw[4][2];
#pragma unroll
                for (int m = 0; m < 4; ++m)
#pragma unroll
                    for (int bj = 0; bj < 2; ++bj) xw[m][bj] = *(const u32x4*)(Xb + (size_t)(row0 + ai * HALF + m * 16) * 1024 + col0 + bj * HALF);
#pragma unroll
                for (int m = 0; m < 4; ++m)
#pragma unroll
                    for (int bj = 0; bj < 2; ++bj) { const u32x4 w = xw[m][bj]; xs[m][bj][0] = (f32x4){bf_lo(w.x), bf_hi(w.x), bf_lo(w.y), bf_hi(w.y)}; xs[m][bj][1] = (f32x4){bf_lo(w.z), bf_hi(w.z), bf_lo(w.w), bf_hi(w.w)}; } }
#pragma unroll
            for (int m = 0; m < 4; ++m) { const int row = row0 + ai * HALF + m * 16; const size_t off = (size_t)row * 1024 + col0; float s1 = 0.f, s2 = 0.f;
#pragma unroll
                for (int bj = 0; bj < 2; ++bj) {
                    const f32x4 y0 = xs[m][bj][0] * ALPHA + acc[ai][bj][m][0], y1 = xs[m][bj][1] * ALPHA + acc[ai][bj][m][1];
                    u32x4 w; w.x = cvt_pk_bf16(y0[0], y0[1]); w.y = cvt_pk_bf16(y0[2], y0[3]); w.z = cvt_pk_bf16(y1[0], y1[1]); w.w = cvt_pk_bf16(y1[2], y1[3]);
                    *(u32x4*)(Y + off + bj * HALF) = w;
                    s1 += ((y0[0] + y0[1]) + (y0[2] + y0[3])) + ((y1[0] + y1[1]) + (y1[2] + y1[3]));
                    s2 += ((y0[0] * y0[0] + y0[1] * y0[1]) + (y0[2] * y0[2] + y0[3] * y0[3])) + ((y1[0] * y1[0] + y1[1] * y1[1]) + (y1[2] * y1[2] + y1[3] * y1[3])); }
                { auto r = __builtin_amdgcn_permlane16_swap(__float_as_uint(s1), __float_as_uint(s1), false, false); s1 = __uint_as_float(r[0]) + __uint_as_float(r[1]); }
                { auto r = __builtin_amdgcn_permlane32_swap(__float_as_uint(s1), __float_as_uint(s1), false, false); s1 = __uint_as_float(r[0]) + __uint_as_float(r[1]); }
                { auto r = __builtin_amdgcn_permlane16_swap(__float_as_uint(s2), __float_as_uint(s2), false, false); s2 = __uint_as_float(r[0]) + __uint_as_float(r[1]); }
                { auto r = __builtin_amdgcn_permlane32_swap(__float_as_uint(s2), __float_as_uint(s2), false, false); s2 = __uint_as_float(r[0]) + __uint_as_float(r[1]); }
                if (fq == 0) { typedef float f32x2v __attribute__((ext_vector_type(2))); *(f32x2v*)(ST + ((size_t)row * 16 + (u.pn & 3) * 4 + wc) * 2) = (f32x2v){s1, s2}; } }
            asm volatile("" ::: "memory"); }
    }
};
__device__ __forceinline__ u32x4 widen8(u32x2 wa, u32x2 wb) {
    auto rx = __builtin_amdgcn_permlane16_swap(wa.x, wb.x, false, false); auto ry = __builtin_amdgcn_permlane16_swap(wa.y, wb.y, false, false);
    u32x4 o; o.x = rx[0]; o.y = ry[0]; o.z = rx[1]; o.w = ry[1]; return o;
}
struct EpiSwiglu {
    static constexpr bool PERM = true;
    unsigned char* ACT; const float* bgu;
    typedef float f2 __attribute__((ext_vector_type(2)));
    static __device__ __forceinline__ f2 act2(f2 ag, f2 au, f2 bg, f2 bu) {
        const f2 g = ag * (1.f / 256.f) + bg, u = au * (1.f / 256.f) + bu;
        f2 hg, hu; hg.x = fminf(g.x, SW_LIMIT); hg.y = fminf(g.y, SW_LIMIT); hu.x = __builtin_amdgcn_fmed3f(u.x, -SW_LIMIT, SW_LIMIT); hu.y = __builtin_amdgcn_fmed3f(u.y, -SW_LIMIT, SW_LIMIT);
        const f2 z = hg * (-SW_ALPHA * 1.4426950408889634f);
        f2 e; e.x = __builtin_amdgcn_exp2f(z.x); e.y = __builtin_amdgcn_exp2f(z.y);
        const f2 d = e + 1.f;
        f2 r; r.x = __builtin_amdgcn_rcpf(d.x); r.y = __builtin_amdgcn_rcpf(d.y);
        const f2 t = hu * 4.f + 4.f;
        return (t * hg) * r;
    }
    __device__ __forceinline__ void operator()(const f32x4 (&acc)[2][2][4][2], const Unit& u, int wr, int wc, int fr, int fq) const {
        const int pnl = u.pn & 7, j0 = pnl * 128 + wc * 32 + 8 * fq;
        const float* bg = bgu + (size_t)u.e * 2048 + j0;
        const f32x4 bg0 = *(const f32x4*)bg, bg1 = *(const f32x4*)(bg + 4), bu0 = *(const f32x4*)(bg + 1024), bu1 = *(const f32x4*)(bg + 1028);
        const int row0 = u.pm * BM + wr * 64 + fr;
        const int odd = fq & 1;
#pragma unroll
        for (int ai = 0; ai < 2; ++ai)
#pragma unroll
            for (int mp = 0; mp < 2; ++mp) { u32x2 w[2];
#pragma unroll
                for (int q = 0; q < 2; ++q) { const int m = 2 * mp + q;
                    const f32x4 g0 = acc[ai][0][m][0], g1 = acc[ai][0][m][1], u0 = acc[ai][1][m][0], u1 = acc[ai][1][m][1];
                    const f2 a00 = act2((f2){g0[0], g0[1]}, (f2){u0[0], u0[1]}, (f2){bg0[0], bg0[1]}, (f2){bu0[0], bu0[1]});
                    const f2 a01 = act2((f2){g0[2], g0[3]}, (f2){u0[2], u0[3]}, (f2){bg0[2], bg0[3]}, (f2){bu0[2], bu0[3]});
                    const f2 a10 = act2((f2){g1[0], g1[1]}, (f2){u1[0], u1[1]}, (f2){bg1[0], bg1[1]}, (f2){bu1[0], bu1[1]});
                    const f2 a11 = act2((f2){g1[2], g1[3]}, (f2){u1[2], u1[3]}, (f2){bg1[2], bg1[3]}, (f2){bu1[2], bu1[3]});
                    w[q].x = cvt4_fp8(a00.x, a00.y, a01.x, a01.y); w[q].y = cvt4_fp8(a10.x, a10.y, a11.x, a11.y); }
                const u32x4 o = widen8(w[0], w[1]);
                const int row = row0 + ai * HALF + (2 * mp + odd) * 16;
                *(u32x4*)(ACT + (size_t)row * 1024 + j0 - 8 * odd) = o; }
    }
};
struct EpiDown {
    static constexpr bool PERM = true;
    unsigned char* YS; const float* bd;
    __device__ __forceinline__ void operator()(const f32x4 (&acc)[2][2][4][2], const Unit& u, int wr, int wc, int fr, int fq) const {
        const int pnl = u.pn & 3, col0 = pnl * 256 + wc * 32 + 8 * fq;
        const float* bp = bd + (size_t)u.e * 1024 + col0;
        f32x4 bv[2][2];
#pragma unroll
        for (int bj = 0; bj < 2; ++bj) { bv[bj][0] = *(const f32x4*)(bp + bj * HALF) * 64.f; bv[bj][1] = *(const f32x4*)(bp + bj * HALF + 4) * 64.f; }
        const int row0 = u.pm * BM + wr * 64 + fr;
        const int odd = fq & 1;
#pragma unroll
        for (int ai = 0; ai < 2; ++ai)
#pragma unroll
            for (int mp = 0; mp < 2; ++mp)
#pragma unroll
                for (int bj = 0; bj < 2; ++bj) { u32x2 w[2];
#pragma unroll
                    for (int q = 0; q < 2; ++q) { const int m = 2 * mp + q; const f32x4 v0 = acc[ai][bj][m][0] * 0.25f + bv[bj][0], v1 = acc[ai][bj][m][1] * 0.25f + bv[bj][1];
                        w[q].x = cvt4_fp8(v0[0], v0[1], v0[2], v0[3]); w[q].y = cvt4_fp8(v1[0], v1[1], v1[2], v1[3]); }
                    const u32x4 o = widen8(w[0], w[1]);
                    const int row = row0 + ai * HALF + (2 * mp + odd) * 16;
                    *(u32x4*)(YS + (size_t)row * 1024 + col0 + bj * HALF - 8 * odd) = o; }
    }
};
}

__device__ __forceinline__ void transpose64(const float* W, int N, bf16* WT, int Kd, int k0, int n0, int drow0, LAS float* scr, int lane) {
    const int c4 = (lane & 15) * 4, kr = lane >> 4;
    f32x4 v[16];
#pragma unroll
    for (int i = 0; i < 16; ++i) v[i] = *(const GAS f32x4*)(W + (size_t)(k0 + 4 * i + kr) * N + n0 + c4);
#pragma unroll
    for (int i = 0; i < 16; ++i) { LAS float* s = scr + (4 * i + kr) * 65 + c4; s[0] = v[i].x; s[1] = v[i].y; s[2] = v[i].z; s[3] = v[i].w; }
    LDS_WAIT(); asm volatile("" ::: "memory");
    const int c = lane & 7;
#pragma unroll
    for (int j = 0; j < 8; ++j) { const int n = (lane >> 3) + 8 * j; const LAS float* s = scr + (8 * c) * 65 + n;
        v4u o; o.x = pk2(s[0 * 65], s[1 * 65]); o.y = pk2(s[2 * 65], s[3 * 65]); o.z = pk2(s[4 * 65], s[5 * 65]); o.w = pk2(s[6 * 65], s[7 * 65]);
        *(GAS v4u*)(WT + (size_t)(drow0 + n) * Kd + k0 + 8 * c) = o; }
    LDS_WAIT(); asm volatile("" ::: "memory");
}

__device__ __forceinline__ void transpose_fp8_128x128(const float* W, int N, unsigned char* WT, int Kd, int k0, int n0, int drow0, float scale, LAS unsigned* scr, int lane) {
    const int c = lane & 31, kr = lane >> 5;
    f32x4 va[4][4], vb[4][4];
#define T8_LOAD(dst, bt_) do { _Pragma("unroll") for (int g = 0; g < 4; ++g) _Pragma("unroll") for (int j = 0; j < 4; ++j) dst[g][j] = *(const GAS f32x4*)(W + (size_t)(k0 + 32 * (bt_) + 8 * g + 4 * kr + j) * N + n0 + 4 * c); } while (0)
#define T8_PUT(src, bt_) do { _Pragma("unroll") for (int g = 0; g < 4; ++g) _Pragma("unroll") for (int i = 0; i < 4; ++i) \
        scr[(4 * c + i) * 33 + 8 * (bt_) + 2 * g + kr] = pg8::cvt4_fp8(src[g][0][i] * scale, src[g][1][i] * scale, src[g][2][i] * scale, src[g][3][i] * scale); } while (0)
    T8_LOAD(va, 0); T8_LOAD(vb, 1);
    T8_PUT(va, 0); asm volatile("" ::: "memory"); T8_LOAD(va, 2);
    T8_PUT(vb, 1); asm volatile("" ::: "memory"); T8_LOAD(vb, 3);
    T8_PUT(va, 2); T8_PUT(vb, 3);
#undef T8_LOAD
#undef T8_PUT
    LDS_WAIT(); asm volatile("" ::: "memory");
    const int kc = lane & 7;
#pragma unroll 4
    for (int j = 0; j < 16; ++j) { const int n = (lane >> 3) + 8 * j; const LAS unsigned* p = scr + n * 33 + 4 * kc;
        v4u o; o.x = p[0]; o.y = p[1]; o.z = p[2]; o.w = p[3];
        *(GAS v4u*)(WT + (size_t)(drow0 + n) * Kd + k0 + 16 * kc) = o; }
    LDS_WAIT(); asm volatile("" ::: "memory");
}

struct Args { const void* in[23]; float* out; unsigned char* ws; int ph_lo, ph_hi; };
typedef const __attribute__((address_space(4))) Args* ArgsP;

__device__ __forceinline__ ArgsP phase_root(Frame& F) {
    int t_ = threadIdx.x; asm volatile("" : "+v"(t_) :: "memory");
    F.tid = t_; F.lane = t_ & 63; F.wave = __builtin_amdgcn_readfirstlane(t_ >> 6);
    ArgsP ka = (ArgsP)__builtin_amdgcn_kernarg_segment_ptr(); asm volatile("" : "+s"(ka) :: "memory");
    F.ws = ka->ws; F.ctl = (gu32*)(F.ws + WS_CTL);
    return ka;
}

__device__ __forceinline__ void p0_prologue(Frame& F, ArgsP A) {
    LAS float* scr = (LAS float*)(F.lds + RING_OFF + F.wave * 16896);
    const int gw = F.vcu * NWAVES + F.wave, NGW = F.G * NWAVES;
    const float* w_in = (const float*)A->in[2]; const float* w_ab = (const float*)A->in[6]; const float* w_out = (const float*)A->in[12];
    const float* w_gu = (const float*)A->in[17]; const float* w_dn = (const float*)A->in[19];
    bf16* Win = (bf16*)(F.ws + WS_WIN); bf16* Wab = (bf16*)(F.ws + WS_WAB); bf16* Wout = (bf16*)(F.ws + WS_WOUT); unsigned char* Wgu = F.ws + WS_WGU; unsigned char* Wd = F.ws + WS_WD;
    constexpr int I_IN = NLAYER * 16 * (GATE0 / 64), I_IN8 = NLAYER * 8 * (GATEW / 128), I_AB = NLAYER * 256, I_OUT = NLAYER * 256, I_GU = NLAYER * NEXP * 128, I_D = NLAYER * NEXP * 64;
    constexpr int NITEMS = I_IN + I_IN8 + I_AB + I_OUT + I_GU + I_D;
    LAS unsigned* scr8 = (LAS unsigned*)(F.lds + RING_OFF + F.wave * 16896);
    for (int it = gw; it < NITEMS; it += NGW) {
        int r = it;
        if (r < I_GU) { const int mat = r >> 7, q = r & 127, kb = q >> 4, nb = q & 15; const int n0 = nb * 128; const int j0 = n0 & 1023;
            const int drow0 = 256 * (j0 >> 7) + ((n0 >= 1024) ? 128 : 0);
            transpose_fp8_128x128(w_gu + (size_t)mat * 1024 * 2048, 2048, Wgu + (size_t)mat * 2048 * 1024, 1024, kb * 128, n0, drow0, 64.f, scr8, F.lane); continue; } r -= I_GU;
        if (r < I_D) { const int mat = r >> 6, q = r & 63, kb = q >> 3, nb = q & 7;
            transpose_fp8_128x128(w_dn + (size_t)mat * 1024 * 1024, 1024, Wd + (size_t)mat * 1024 * 1024, 1024, kb * 128, nb * 128, nb * 128, 64.f, scr8, F.lane); continue; } r -= I_D;
        if (r < I_IN8) { const int mat = r >> 7, q = r & 127, kb = q >> 4, nb = q & 15;
            transpose_fp8_128x128(w_in + (size_t)mat * 1024 * INW, INW, F.ws + WS_WIN8 + (size_t)mat * GATEW * 1024, 1024, kb * 128, GATE0 + nb * 128, nb * 128, 64.f, scr8, F.lane); continue; } r -= I_IN8;
        if (r < I_IN) { const int mat = r / (16 * 56), q = r % (16 * 56), kb = q / 56, nb = q % 56;
            transpose64(w_in + (size_t)mat * 1024 * INW, INW, Win + (size_t)mat * INW * 1024, 1024, kb * 64, nb * 64, nb * 64, scr, F.lane); continue; } r -= I_IN;
        if (r < I_AB) { const int mat = r >> 8, q = r & 255, kb = q >> 4, nb = q & 15;
            transpose64(w_ab + (size_t)mat * 1024 * 1024, 1024, Wab + (size_t)mat * 1024 * 1024, 1024, kb * 64, nb * 64, nb * 64, scr, F.lane); continue; } r -= I_AB;
        { const int mat = r >> 8, q = r & 255, kb = q >> 4, nb = q & 15;
            transpose64(w_out + (size_t)mat * 1024 * 1024, 1024, Wout + (size_t)mat * 1024 * 1024, 1024, kb * 64, nb * 64, nb * 64, scr, F.lane); }
    }
    const int gt = F.vcu * NTHR + F.tid, NGT = F.G * NTHR;
    { const float* x = (const float*)A->in[0]; bf16* XB = (bf16*)(F.ws + WS_XB);
#pragma unroll 4
      for (int i = gt; i < TOK * DMODEL / 8; i += NGT) { const f32x4 a = *(const GAS f32x4*)(x + (size_t)i * 8), b = *(const GAS f32x4*)(x + (size_t)i * 8 + 4);
          v4u o; o.x = pk2(a.x, a.y); o.y = pk2(a.z, a.w); o.z = pk2(b.x, b.y); o.w = pk2(b.z, b.w); *(GAS v4u*)(XB + (size_t)i * 8) = o;
          v2u q; q.x = pg8::cvt4_fp8(4.f * a.x, 4.f * a.y, 4.f * a.z, 4.f * a.w); q.y = pg8::cvt4_fp8(4.f * b.x, 4.f * b.y, 4.f * b.z, 4.f * b.w); *(GAS v2u*)(F.ws + WS_XB8 + (size_t)i * 8) = q; } }
    { const int* pos = (const int*)A->in[1]; float* cs = (float*)(F.ws + WS_CS);
      for (int i = gt; i < TOK * 8; i += NGT) { const int t = i >> 3, f = i & 7;
          const float invf = exp2f(-(float)f * 2.3664460711655218f);
          const float ang = (float)pos[t] * invf;
          double rev = (double)ang * 0.15915494309189535; rev -= rint(rev); const float fr = (float)rev;
          cs[(size_t)t * 16 + f] = __builtin_amdgcn_cosf(fr); cs[(size_t)t * 16 + 8 + f] = __builtin_amdgcn_sinf(fr); } }
    { const float* wr = (const float*)A->in[15]; bf16* wrh = (bf16*)(F.ws + WS_WRT); bf16* wrl = wrh + NLAYER * 32 * 1024;
      for (int i = gt; i < NLAYER * 32 * 1024; i += NGT) { const int l = i >> 15, e = (i >> 10) & 31, c = i & 1023; const float w = wr[(size_t)l * 32768 + c * 32 + e];
          const unsigned h = f2bf(w); wrh[i] = (bf16)h; wrl[i] = (bf16)f2bf(w - __uint_as_float(h << 16)); } }
    { const float* pw = (const float*)A->in[3]; const float* ps = (const float*)A->in[4]; const float* wpb = (const float*)A->in[5]; bf16* WPF = (bf16*)(F.ws + WS_WPF);
      for (int i = gt; i < NLAYER * 64 * 1024; i += NGT) { const int n = i & 1023; const int kgl = __builtin_amdgcn_readfirstlane(i >> 10), kg = kgl & 63, l = kgl >> 6, g = kg >> 4, c0 = (kg & 15) * 8;
          const float* pr = pw + ((size_t)(l * 4 + g) * 128 + c0) * 128; const float* sr = ps + l * 512 + g * 128; const float* br = wpb + ((size_t)l * 512 + g * 128) * 1024 + n;
          float acc[8] = {0.f, 0.f, 0.f, 0.f, 0.f, 0.f, 0.f, 0.f};
#pragma unroll 8
          for (int d = 0; d < 128; ++d) { const float bv = br[(size_t)d * 1024] * sr[d];
#pragma unroll
              for (int j = 0; j < 8; ++j) acc[j] = fmaf(pr[j * 128 + d], bv, acc[j]); }
          v4u o; o.x = pk2(acc[0], acc[1]); o.y = pk2(acc[2], acc[3]); o.z = pk2(acc[4], acc[5]); o.w = pk2(acc[6], acc[7]);
          *(GAS v4u*)(WPF + ((size_t)l * 1024 + n) * 512 + g * 128 + c0) = o; } }
}

template <int W> __device__ __forceinline__ void pool_item(const bf16* U, bf16* Dp, int t, int col) {
    const int s = t & (SEQ - 1), n = (s + 1 < W) ? s + 1 : W;
    const bf16* p = U + (size_t)t * POOLW + col;
    v4u v[W];
#pragma unroll
    for (int k = 0; k < W; ++k) v[k] = *(const GAS v4u*)(p - (size_t)((k <= s) ? k : 0) * POOLW);
    float a[8] = {bf_lo(v[0].x), bf_hi(v[0].x), bf_lo(v[0].y), bf_hi(v[0].y), bf_lo(v[0].z), bf_hi(v[0].z), bf_lo(v[0].w), bf_hi(v[0].w)};
    float sm[8];
#pragma unroll
    for (int j = 0; j < 8; ++j) sm[j] = a[j];
#pragma unroll
    for (int k = 1; k < W; ++k) { const float m = (k <= s) ? 1.f : 0.f;
        sm[0] += m * bf_lo(v[k].x); sm[1] += m * bf_hi(v[k].x); sm[2] += m * bf_lo(v[k].y); sm[3] += m * bf_hi(v[k].y); sm[4] += m * bf_lo(v[k].z); sm[5] += m * bf_hi(v[k].z); sm[6] += m * bf_lo(v[k].w); sm[7] += m * bf_hi(v[k].w); }
    const float inv = 1.f / (float)n;
    v4u o; o.x = pk2(sm[0] * inv - a[0], sm[1] * inv - a[1]); o.y = pk2(sm[2] * inv - a[2], sm[3] * inv - a[3]); o.z = pk2(sm[4] * inv - a[4], sm[5] * inv - a[5]); o.w = pk2(sm[6] * inv - a[6], sm[7] * inv - a[7]);
    *(GAS v4u*)(Dp + (size_t)t * POOLW + col) = o;
}
__device__ __forceinline__ void pool_phase(Frame& F) {
    const bf16* U = (const bf16*)(F.ws + WS_U); bf16* Dp = (bf16*)(F.ws + WS_DP);
    const int gt = F.vcu * NTHR + F.tid, NGT = F.G * NTHR;
    for (int i = gt; i < TOK * 64; i += NGT) { const int g = __builtin_amdgcn_readfirstlane(i / (TOK * 16)), r = i - g * (TOK * 16), t = r >> 4, col = g * 128 + (r & 15) * 8;
        if (g == 0) pool_item<2>(U, Dp, t, col); else if (g == 1) pool_item<4>(U, Dp, t, col); else if (g == 2) pool_item<8>(U, Dp, t, col); else pool_item<16>(U, Dp, t, col); }
}

constexpr int WR_ROWB = 2064;
constexpr int WR_LO_OFF = 32 * WR_ROWB;
constexpr int RT_SC_OFF = 2 * WR_LO_OFF;
static_assert(RT_SC_OFF + 2 * 8 * 32 * 4 <= RING_BYTES, "router LDS");
__device__ __forceinline__ void router_phase(Frame& F, ArgsP A, int l) {
    typedef short bf16x8 __attribute__((ext_vector_type(8)));
    const bf16* Y = (const bf16*)(F.ws + WS_Y); const float* ST = (const float*)(F.ws + WS_STATS) + (size_t)l * TOK * 32; unsigned char* X1Q = F.ws + WS_X1B;
    int* TOKE = (int*)(F.ws + WS_TOKE); float* TOKG = (float*)(F.ws + WS_TOKG); int* RTOK = (int*)(F.ws + WS_RTOK);
    const bf16* wrh = (const bf16*)(F.ws + WS_WRT) + (size_t)l * 32768; const bf16* wrl = wrh + NLAYER * 32768;
    for (int i = F.tid; i < 32 * 128; i += NTHR) { const int e = i >> 7, c = i & 127;
        *(LAS v4u*)(F.lds + RING_OFF + e * WR_ROWB + c * 16) = *(const GAS v4u*)(wrh + (size_t)e * 1024 + c * 8);
        *(LAS v4u*)(F.lds + RING_OFF + WR_LO_OFF + e * WR_ROWB + c * 16) = *(const GAS v4u*)(wrl + (size_t)e * 1024 + c * 8); }
    __syncthreads();
    const float* lg = (const float*)A->in[13] + l * 1024; const float* lb = (const float*)A->in[14] + l * 1024;
    const float* brp = (const float*)A->in[16] + l * 32;
    unsigned* cursor = (unsigned*)(F.ctl + CW_CURSOR + l * 32 * 64);
    LAS int* sc = (LAS int*)(F.lds + RING_OFF + RT_SC_OFF);
    const int gw = F.vcu * NWAVES + F.wave, NGW = F.G * NWAVES, lane = F.lane, row = lane & 15, kq = lane >> 4;
    const LAS unsigned char* wb = F.lds + RING_OFF + row * WR_ROWB + kq * 16;
    for (int bt = gw; bt < TOK / 16; bt += NGW) {
        const size_t roff = (size_t)(bt * 16 + row) * 1024 + kq * 8;
        const bf16* yr = Y + roff;
        float s1 = 0.f, s2 = 0.f;
        { const GAS f32x4* sp = (const GAS f32x4*)(ST + (size_t)(bt * 16 + row) * 32);
#pragma unroll
          for (int i = 0; i < 8; ++i) { const f32x4 p = sp[i]; s1 += p.x; s2 += p.y; s1 += p.z; s2 += p.w; } }
        const float mean = s1 * (1.f / 1024.f); const float var = fmaxf(s2 * (1.f / 1024.f) - mean * mean, 0.f); const float rstd = 1.f / sqrtf(var + LN_EPS);
        f32x4 acc0 = {0.f, 0.f, 0.f, 0.f}, acc1 = acc0;
        unsigned char* xq = X1Q + roff;
#pragma unroll 16
        for (int s = 0; s < 32; ++s) {
            const v4u yw = *(const GAS v4u*)(yr + 32 * s);
            f32x4 a = {bf_lo(yw.x), bf_hi(yw.x), bf_lo(yw.y), bf_hi(yw.y)}, b = {bf_lo(yw.z), bf_hi(yw.z), bf_lo(yw.w), bf_hi(yw.w)};
            const f32x4 g0 = *(const GAS f32x4*)(lg + 32 * s + kq * 8), g1 = *(const GAS f32x4*)(lg + 32 * s + kq * 8 + 4);
            const f32x4 b0 = *(const GAS f32x4*)(lb + 32 * s + kq * 8), b1 = *(const GAS f32x4*)(lb + 32 * s + kq * 8 + 4);
            a = (a - mean) * rstd * g0 + b0; b = (b - mean) * rstd * g1 + b1;
            v4u h; h.x = pk2(a.x, a.y); h.y = pk2(a.z, a.w); h.z = pk2(b.x, b.y); h.w = pk2(b.z, b.w);
            { v2u q; q.x = pg8::cvt4_fp8(4.f * a.x, 4.f * a.y, 4.f * a.z, 4.f * a.w); q.y = pg8::cvt4_fp8(4.f * b.x, 4.f * b.y, 4.f * b.z, 4.f * b.w); *(GAS v2u*)(xq + 32 * s) = q; }
            v4u lo; lo.x = pk2(a.x - bf_lo(h.x), a.y - bf_hi(h.x)); lo.y = pk2(a.z - bf_lo(h.y), a.w - bf_hi(h.y)); lo.z = pk2(b.x - bf_lo(h.z), b.y - bf_hi(h.z)); lo.w = pk2(b.z - bf_lo(h.w), b.w - bf_hi(h.w));
            const bf16x8 ah = __builtin_bit_cast(bf16x8, h), al = __builtin_bit_cast(bf16x8, lo);
            const bf16x8 wh0 = *(const LAS bf16x8*)(wb + 64 * s), wh1 = *(const LAS bf16x8*)(wb + 16 * WR_ROWB + 64 * s);
            const bf16x8 wl0 = *(const LAS bf16x8*)(wb + WR_LO_OFF + 64 * s), wl1 = *(const LAS bf16x8*)(wb + WR_LO_OFF + 16 * WR_ROWB + 64 * s);
            acc0 = __builtin_amdgcn_mfma_f32_16x16x32_bf16(wh0, ah, acc0, 0, 0, 0); acc1 = __builtin_amdgcn_mfma_f32_16x16x32_bf16(wh1, ah, acc1, 0, 0, 0);
            acc0 = __builtin_amdgcn_mfma_f32_16x16x32_bf16(wh0, al, acc0, 0, 0, 0); acc1 = __builtin_amdgcn_mfma_f32_16x16x32_bf16(wh1, al, acc1, 0, 0, 0);
            acc0 = __builtin_amdgcn_mfma_f32_16x16x32_bf16(wl0, ah, acc0, 0, 0, 0); acc1 = __builtin_amdgcn_mfma_f32_16x16x32_bf16(wl1, ah, acc1, 0, 0, 0);
        }
        unsigned key[8];
        { const f32x4 br0 = *(const GAS f32x4*)(brp + 4 * kq), br1 = *(const GAS f32x4*)(brp + 16 + 4 * kq);
#pragma unroll
          for (int i = 0; i < 4; ++i) { unsigned u0 = __float_as_uint(acc0[i] + br0[i]), u1 = __float_as_uint(acc1[i] + br1[i]);
              u0 = (u0 & 0x80000000u) ? ~u0 : (u0 | 0x80000000u); u1 = (u1 & 0x80000000u) ? ~u1 : (u1 | 0x80000000u);
              key[i] = (u0 & ~31u) | (unsigned)(31 - (4 * kq + i)); key[4 + i] = (u1 & ~31u) | (unsigned)(31 - (16 + 4 * kq + i)); } }
        float sv[4]; int se[4];
#pragma unroll
        for (int k = 0; k < 4; ++k) { unsigned m = key[0];
#pragma unroll
            for (int i = 1; i < 8; ++i) m = m > key[i] ? m : key[i];
            { auto r = __builtin_amdgcn_permlane16_swap(m, m, false, false); m = r[0] > r[1] ? r[0] : r[1]; }
            { auto r = __builtin_amdgcn_permlane32_swap(m, m, false, false); m = r[0] > r[1] ? r[0] : r[1]; }
            se[k] = 31 - (int)(m & 31u); const unsigned ub = m & ~31u; sv[k] = __uint_as_float((ub & 0x80000000u) ? (ub & 0x7fffffffu) : ~ub);
#pragma unroll
            for (int i = 0; i < 8; ++i) key[i] = (key[i] == m) ? 0u : key[i]; }
        const float e1 = __expf(sv[1] - sv[0]), e2 = __expf(sv[2] - sv[0]), e3 = __expf(sv[3] - sv[0]); const float inv = 1.f / (1.f + e1 + e2 + e3);
        const int my_e = (kq == 0) ? se[0] : (kq == 1) ? se[1] : (kq == 2) ? se[2] : se[3];
        const float my_g = ((kq == 0) ? 1.f : (kq == 1) ? e1 : (kq == 2) ? e2 : e3) * inv;
        unsigned long long mymask = 0ull; int mycnt = 0;
#pragma unroll 1
        for (int e = 0; e < 32; ++e) { const unsigned long long m = __ballot(my_e == e); if (my_e == e) mymask = m; if (lane == e) mycnt = __popcll(m); }
        if (lane < 32) sc[F.wave * 32 + lane] = mycnt;
        __syncthreads();
        if (F.wave == 0 && lane < 32) { int tot = 0;
#pragma unroll
            for (int w = 0; w < 8; ++w) { const int c = sc[w * 32 + lane]; sc[256 + w * 32 + lane] = tot; tot += c; }
            int base = 0; if (tot > 0) base = (int)__hip_atomic_fetch_add(cursor + lane * 64, (unsigned)tot, RLX_AGENT);
#pragma unroll
            for (int w = 0; w < 8; ++w) sc[256 + w * 32 + lane] += base; }
        __syncthreads();
        const int rank = sc[256 + F.wave * 32 + my_e] + __popcll(mymask & ((1ull << lane) - 1ull));
        const int t = bt * 16 + row;
        TOKE[t * 4 + kq] = my_e | (rank << 8); TOKG[t * 4 + kq] = my_g;
        RTOK[(size_t)my_e * CAP + rank] = t;
        __syncthreads();
    }
}

__device__ __forceinline__ void moe_tables(Frame& F, int l) {
    __syncthreads();
    if (F.wave == 0) { const int lane = F.lane;
        const unsigned c = (lane < 32) ? __hip_atomic_load(F.ctl + CW_CURSOR + (l * 32 + lane) * 64, RLX_AGENT) : 0u; const unsigned nbk = (c + 255u) >> 8;
        unsigned incl = nbk;
#pragma unroll
        for (int d = 1; d < 32; d <<= 1) { const unsigned t = (unsigned)__shfl_up((int)incl, d); if ((lane & 31) >= d) incl += t; }
        const unsigned excl = incl - nbk;
        if (lane < 32) { F.MISC[TAB_CNT + lane] = c; F.MISC[TAB_BLK + lane] = excl; for (unsigned rb = excl; rb < incl; ++rb) F.MISC[TAB_RB + rb] = (unsigned)lane; }
        if (lane == 31) F.MISC[TAB_BLK + 32] = incl; }
    __syncthreads();
}

__device__ __forceinline__ void final_phase(Frame& F, ArgsP A, int l, float* OUT, bf16* XBo) {
    typedef int i32x4 __attribute__((ext_vector_type(4)));
    const bf16* Y = (const bf16*)(F.ws + WS_Y); const float* ST = (const float*)(F.ws + WS_STATS) + (size_t)l * TOK * 32; const unsigned char* YS = F.ws + WS_YS;
    const int* TOKE = (const int*)(F.ws + WS_TOKE); const float* TOKG = (const float*)(F.ws + WS_TOKG);
    const int gw = F.vcu * NWAVES + F.wave, NGW = F.G * NWAVES, lane = F.lane;
    f32x4 g1v[2][2], b1v[2][2], lgv[2][2], lbv[2][2];
#pragma unroll
    for (int j = 0; j < 2; ++j)
#pragma unroll
        for (int h = 0; h < 2; ++h) { const int c = l * 1024 + 512 * j + 8 * lane + 4 * h;
            g1v[j][h] = *(const GAS f32x4*)((const float*)A->in[13] + c); b1v[j][h] = *(const GAS f32x4*)((const float*)A->in[14] + c);
            lgv[j][h] = *(const GAS f32x4*)((const float*)A->in[21] + c); lbv[j][h] = *(const GAS f32x4*)((const float*)A->in[22] + c); }
    constexpr int TPI = 4;
    for (int t0 = gw * TPI; t0 < TOK; t0 += NGW * TPI) {
        i32x4 er[TPI]; f32x4 gt[TPI]; float sv[TPI];
#pragma unroll
        for (int q = 0; q < TPI; ++q) { er[q] = *(const GAS i32x4*)(TOKE + (size_t)(t0 + q) * 4); gt[q] = *(const GAS f32x4*)(TOKG + (size_t)(t0 + q) * 4);
            sv[q] = ST[(size_t)(t0 + q) * 32 + (lane & 31)]; }
        v4u yw[TPI][2]; v2u sw[TPI][4][2];
#pragma unroll
        for (int q = 0; q < TPI; ++q) { const GAS v4u* xr = (const GAS v4u*)(Y + (size_t)(t0 + q) * 1024) + lane;
#pragma unroll
            for (int j = 0; j < 2; ++j) yw[q][j] = xr[64 * j]; }
#pragma unroll
        for (int q = 0; q < TPI; ++q)
#pragma unroll
            for (int k = 0; k < 4; ++k) { const int e = er[q][k] & 255, rank = er[q][k] >> 8; const size_t row = (size_t)F.MISC[TAB_BLK + e] * 256 + rank;
                const GAS v2u* yr = (const GAS v2u*)(YS + row * 1024) + lane;
#pragma unroll
                for (int j = 0; j < 2; ++j) sw[q][k][j] = yr[64 * j]; }
#pragma unroll
        for (int q = 0; q < TPI; ++q) { const int t = t0 + q;
            f32x4 v[2][2];
            { const float s1 = wave_sum((lane < 32 && !(lane & 1)) ? sv[q] : 0.f), s2 = wave_sum((lane < 32 && (lane & 1)) ? sv[q] : 0.f);
              const float mean1 = s1 * (1.f / 1024.f); const float var1 = fmaxf(s2 * (1.f / 1024.f) - mean1 * mean1, 0.f); const float rstd1 = 1.f / sqrtf(var1 + LN_EPS);
#pragma unroll
              for (int j = 0; j < 2; ++j) { const v4u w = yw[q][j]; const f32x4 y0 = {bf_lo(w.x), bf_hi(w.x), bf_lo(w.y), bf_hi(w.y)}, y1 = {bf_lo(w.z), bf_hi(w.z), bf_lo(w.w), bf_hi(w.w)};
                  v[j][0] = ((y0 - mean1) * rstd1 * g1v[j][0] + b1v[j][0]) * ALPHA; v[j][1] = ((y1 - mean1) * rstd1 * g1v[j][1] + b1v[j][1]) * ALPHA; } }
#pragma unroll
            for (int k = 0; k < 4; ++k) { const float g = gt[q][k] * (1.f / 64.f);
#pragma unroll
                for (int j = 0; j < 2; ++j) { const v2u w = sw[q][k][j];
                    const f32x2 a0 = __builtin_amdgcn_cvt_pk_f32_fp8((int)w.x, false), a1 = __builtin_amdgcn_cvt_pk_f32_fp8((int)w.x, true), a2 = __builtin_amdgcn_cvt_pk_f32_fp8((int)w.y, false), a3 = __builtin_amdgcn_cvt_pk_f32_fp8((int)w.y, true);
                    v[j][0].x += g * a0.x; v[j][0].y += g * a0.y; v[j][0].z += g * a1.x; v[j][0].w += g * a1.y; v[j][1].x += g * a2.x; v[j][1].y += g * a2.y; v[j][1].z += g * a3.x; v[j][1].w += g * a3.y; } }
            float s = 0.f;
#pragma unroll
            for (int j = 0; j < 2; ++j)
#pragma unroll
                for (int h = 0; h < 2; ++h) s += (v[j][h].x + v[j][h].y) + (v[j][h].z + v[j][h].w);
            const float mean = wave_sum(s) * (1.f / 1024.f); float s2 = 0.f;
#pragma unroll
            for (int j = 0; j < 2; ++j)
#pragma unroll
                for (int h = 0; h < 2; ++h) { v[j][h] = v[j][h] - mean; s2 += (v[j][h].x * v[j][h].x + v[j][h].y * v[j][h].y) + (v[j][h].z * v[j][h].z + v[j][h].w * v[j][h].w); }
            const float rstd = 1.f / sqrtf(wave_sum(s2) * (1.f / 1024.f) + LN_EPS);
#pragma unroll
            for (int j = 0; j < 2; ++j)
#pragma unroll
                for (int h = 0; h < 2; ++h) v[j][h] = v[j][h] * rstd * lgv[j][h] + lbv[j][h];
            if (OUT) { float* xo = OUT + (size_t)t * 1024 + 8 * lane;
#pragma unroll
                for (int j = 0; j < 2; ++j) { *(GAS f32x4*)(xo + 512 * j) = v[j][0]; *(GAS f32x4*)(xo + 512 * j + 4) = v[j][1]; } }
            if (XBo) { bf16* xb = XBo + (size_t)t * 1024 + 8 * lane;
#pragma unroll
                for (int j = 0; j < 2; ++j) { v4u o; o.x = pk2(v[j][0].x, v[j][0].y); o.y = pk2(v[j][0].z, v[j][0].w); o.z = pk2(v[j][1].x, v[j][1].y); o.w = pk2(v[j][1].z, v[j][1].w); *(GAS v4u*)(xb + 512 * j) = o;
                    v2u q; q.x = pg8::cvt4_fp8(4.f * v[j][0].x, 4.f * v[j][0].y, 4.f * v[j][0].z, 4.f * v[j][0].w); q.y = pg8::cvt4_fp8(4.f * v[j][1].x, 4.f * v[j][1].y, 4.f * v[j][1].z, 4.f * v[j][1].w);
                    *(GAS v2u*)(F.ws + WS_XB8 + (size_t)t * 1024 + 8 * lane + 512 * j) = q; } }
        }
    }
}

constexpr int PH_PER_LAYER = 9, NPHASE = 1 + NLAYER * PH_PER_LAYER;
__global__ void __launch_bounds__(NTHR, 2) mega_fwd(Args args) {
    extern __shared__ __attribute__((aligned(16))) unsigned char lds[];
    Frame F;
    F.lds = (LAS unsigned char*)lds;
    F.MISC = (volatile LAS unsigned*)(F.lds + MISC_OFF);
    F.tid = threadIdx.x; F.lane = F.tid & 63; F.wave = __builtin_amdgcn_readfirstlane(F.tid >> 6);
    F.G = gridDim.x; { const int bx = blockIdx.x; F.vcu = (F.G % 8 == 0) ? (bx % 8) * (F.G / 8) + bx / 8 : bx; }
    F.ws = args.ws; F.ctl = (gu32*)(args.ws + WS_CTL);
    for (int u = F.tid; u < (LDS_BYTES - MISC_OFF) / 4; u += NTHR) ((LAS unsigned*)(F.lds + MISC_OFF))[u] = 0u;
    __syncthreads();
#if MK_MULTI
#define GRID_BAR() do { } while (0)
#else
    XcdBarrier bar = xcd_barrier_post((unsigned*)(F.ctl + CW_BAR), F.MISC + 8);
#define GRID_BAR() xcd_barrier(bar)
#endif
    const int lo = args.ph_lo, hi = args.ph_hi;
#ifndef PHMASK
#define PHMASK 0x3ff
#endif
#define PH_ON(n) (((PHMASK) >> (n)) & 1)
#define IN(k) (lo <= (k) && (k) < hi)
#define SEAM(k) do { if (IN((k) + 1)) GRID_BAR(); } while (0)

    if (PH_ON(0) && IN(0)) { ArgsP A = phase_root(F); p0_prologue(F, A); SEAM(0); }

#pragma unroll 1
    for (int l = 0; l < NLAYER; ++l) {
        const int pb = 1 + l * PH_PER_LAYER;
        if (PH_ON(1) && IN(pb + 0)) {
            (void)phase_root(F);
            { pg8::Gemm g{(const pg8::bf16_t*)(F.ws + WS_XB), (const pg8::bf16_t*)(F.ws + WS_WIN) + (size_t)l * INW * 1024, TOK, GATE0, 1024};
              pg8::StaticOrder S; S.init(TOK, GATE0, F.G, (int)blockIdx.x);
              pg8::EpiInProj E{(pg8::bf16_t*)(F.ws + WS_U), (pg8::bf16_t*)(F.ws + WS_Q), (pg8::bf16_t*)(F.ws + WS_K), (pg8::bf16_t*)(F.ws + WS_V), (pg8::bf16_t*)(F.ws + WS_G), (const float*)(F.ws + WS_CS), 0, 1.f};
              { const pg8::TableOrder TO = unit_table(F, S); pg8::gemm_phase<pg8::EpiInProj, pg8::TableOrder, true, true, false>(F.lds + RING_OFF, g, TO, E); } }
            VM_WAIT(); __syncthreads();
            (void)phase_root(F);
            { pg8::Gemm g{(const pg8::bf16_t*)(F.ws + WS_XB8), (const pg8::bf16_t*)(F.ws + WS_WIN8 + (size_t)l * GATEW * 1024), TOK, GATEW, 512};
              pg8::StaticOrder S; S.init(TOK, GATEW, F.G, (int)blockIdx.x);
              pg8::EpiInProj E{(pg8::bf16_t*)(F.ws + WS_U), (pg8::bf16_t*)(F.ws + WS_Q), (pg8::bf16_t*)(F.ws + WS_K), (pg8::bf16_t*)(F.ws + WS_V), (pg8::bf16_t*)(F.ws + WS_G), (const float*)(F.ws + WS_CS), 14, 1.f / 256.f};
              { const pg8::TableOrder TO = unit_table(F, S); pg8::gemm_phase<pg8::EpiInProj, pg8::TableOrder, true, true, false, true>(F.lds + RING_OFF, g, TO, E); } }
            SEAM(pb + 0);
        }
        if (PH_ON(2) && IN(pb + 1)) {
            (void)phase_root(F);
            pool_phase(F);
            VM_WAIT(); __syncthreads();
            { ArgsP A = phase_root(F);
              const float linit = (l == 0) ? 0.2f : (0.8f - 0.6f * 0.74081822068171788f);
              const float a1 = ((const float*)A->in[7])[l * 64 + F.lane] * ((const float*)A->in[8])[l * 64 + F.lane];
              const float a2 = ((const float*)A->in[9])[l * 64 + F.lane] * ((const float*)A->in[10])[l * 64 + F.lane];
              const float lam = expf(wave_sum(a1)) - expf(wave_sum(a2)) + linit;
              const float* swp = (const float*)A->in[11] + l * 128;
              float* blob = (float*)(F.ws + WS_O1) + (size_t)(F.vcu * NWAVES + F.wave) * 4096;
#define ATT_DECODE(idx_, b_, h_, qb_) const int j_##b_ = (idx_) & 7, tm_##b_ = ((idx_) >> 3) & 31, r_##b_ = (idx_) >> 8, bh_##b_ = tm_##b_ * 4 + r_##b_, b_ = bh_##b_ >> 3, h_ = bh_##b_ & 7; \
                  const int qb_ = (r_##b_ == 0) ? j_##b_ : (r_##b_ == 1) ? 7 - j_##b_ : (r_##b_ == 2) ? ((j_##b_ + 4) & 7) : 7 - ((j_##b_ + 4) & 7)
              const attn_body::bf16* Qb = (const attn_body::bf16*)(F.ws + WS_Q); const attn_body::bf16* Kb = (const attn_body::bf16*)(F.ws + WS_K); const attn_body::bf16* Vb = (const attn_body::bf16*)(F.ws + WS_V);
#pragma unroll 1
              for (int rep = 0; rep < REP_ATTN; ++rep) {
                  if (F.vcu < BATCH * 8 * 8) { ATT_DECODE(F.vcu, b0, h0, qb0); (void)qb0; attn_body::attn_prime((long)b0 * SEQ, Kb + h0 * 128, Vb + h0 * 128, (char*)lds + RING_OFF); }
#pragma unroll 1
                  for (int idx = F.vcu; idx < BATCH * 8 * 8; idx += F.G) {
                      ATT_DECODE(idx, b, h, qb);
                      const int nidx = idx + F.G; const int non = nidx < BATCH * 8 * 8; ATT_DECODE(non ? nidx : idx, nb, nh, nqb); (void)nqb;
                      const attn_body::PrimeNext nx{(long)nb * SEQ, Kb + nh * 128, Vb + nh * 128, non};
                      attn_body::diff_attn_unit((long)b * SEQ, qb, Qb + h * 128, Kb + h * 128, Qb + h * 128 + 64, Kb + h * 128 + 64, Vb + h * 128, (attn_body::bf16*)(F.ws + WS_ON) + h * 128, blob, lam, swp, 1.f - linit, (char*)lds + RING_OFF, nx);
                  }
              }
#undef ATT_DECODE
            }
            SEAM(pb + 1);
        }
        if (PH_ON(4) && IN(pb + 3)) {
            (void)phase_root(F);
            { pg8::Gemm g{(const pg8::bf16_t*)(F.ws + WS_DP), (const pg8::bf16_t*)(F.ws + WS_WPF) + (size_t)l * 1024 * 512, TOK, 1024, 512};
              pg8::StaticOrder S; S.init(TOK, 1024, F.G, (int)blockIdx.x);
              pg8::EpiGate0 E{(pg8::bf16_t*)(F.ws + WS_MRG), (const pg8::bf16_t*)(F.ws + WS_G)};
              { const pg8::TableOrder TO = unit_table(F, S); pg8::gemm_phase<pg8::EpiGate0, pg8::TableOrder, true, true, false>(F.lds + RING_OFF, g, TO, E); } }
            VM_WAIT(); __syncthreads();
            (void)phase_root(F);
            { pg8::Gemm g{(const pg8::bf16_t*)(F.ws + WS_ON), (const pg8::bf16_t*)(F.ws + WS_WAB) + (size_t)l * 1024 * 1024, TOK, 1024, 1024};
              pg8::StaticOrder S; S.init(TOK, 1024, F.G, (int)blockIdx.x);
              pg8::EpiGate1 E{(const pg8::bf16_t*)(F.ws + WS_G), (pg8::bf16_t*)(F.ws + WS_MRG)};
              { const pg8::TableOrder TO = unit_table(F, S); pg8::gemm_phase<pg8::EpiGate1, pg8::TableOrder, true, true, false>(F.lds + RING_OFF, g, TO, E); } }
            SEAM(pb + 3);
        }
        if (PH_ON(5) && IN(pb + 4)) {
            ArgsP A = phase_root(F);
            pg8::Gemm g{(const pg8::bf16_t*)(F.ws + WS_MRG), (const pg8::bf16_t*)(F.ws + WS_WOUT) + (size_t)l * 1024 * 1024, TOK, 1024, 1024};
            pg8::StaticOrder S; S.init(TOK, 1024, F.G, (int)blockIdx.x);
            pg8::EpiOut E{(l == 0) ? (const float*)A->in[0] : nullptr, (const pg8::bf16_t*)(F.ws + WS_XB), (pg8::bf16_t*)(F.ws + WS_Y), (float*)(F.ws + WS_STATS) + (size_t)l * TOK * 32};
            { const pg8::TableOrder TO = unit_table(F, S); pg8::gemm_phase<pg8::EpiOut, pg8::TableOrder, true, true, false>(F.lds + RING_OFF, g, TO, E); }
            SEAM(pb + 4);
        }
        if (PH_ON(6) && IN(pb + 5)) { ArgsP A = phase_root(F); router_phase(F, A, l); SEAM(pb + 5); }
        if (PH_ON(7) && IN(pb + 6)) {
            ArgsP A = phase_root(F);
            moe_tables(F, l);
            pg8::Gemm g{(const pg8::bf16_t*)(F.ws + WS_X1B), (const pg8::bf16_t*)(F.ws + WS_WGU + (size_t)l * NEXP * 2048 * 1024), TOK, 2048, 512};
            pg8::MoeOrder S{(const LAS int*)(F.lds + MISC_OFF) + TAB_BLK, (const LAS int*)(F.lds + MISC_OFF) + TAB_CNT, (const int*)(F.ws + WS_RTOK), 3, F.G, F.vcu, CAP};
            pg8::EpiSwiglu E{F.ws + WS_ACT, (const float*)A->in[18] + (size_t)l * NEXP * 2048};
            pg8::gemm_phase<pg8::EpiSwiglu, pg8::MoeOrder, true, true, true, true>(F.lds + RING_OFF, g, S, E);
            SEAM(pb + 6);
        }
        if (PH_ON(8) && IN(pb + 7)) {
            ArgsP A = phase_root(F);
            moe_tables(F, l);
            pg8::Gemm g{(const pg8::bf16_t*)(F.ws + WS_ACT), (const pg8::bf16_t*)(F.ws + WS_WD + (size_t)l * NEXP * 1024 * 1024), MAXROWS, 1024, 512};
            pg8::MoeOrder S{(const LAS int*)(F.lds + MISC_OFF) + TAB_BLK, (const LAS int*)(F.lds + MISC_OFF) + TAB_CNT, (const int*)(F.ws + WS_RTOK), 2, F.G, F.vcu, CAP};
            pg8::EpiDown E{F.ws + WS_YS, (const float*)A->in[20] + (size_t)l * NEXP * 1024};
            pg8::gemm_phase<pg8::EpiDown, pg8::MoeOrder, true, true, false, true>(F.lds + RING_OFF, g, S, E);
            SEAM(pb + 7);
        }
        if (PH_ON(9) && IN(pb + 8)) {
            ArgsP A = phase_root(F);
            moe_tables(F, l);
            final_phase(F, A, l, (l == NLAYER - 1) ? A->out : nullptr, (l == NLAYER - 1) ? nullptr : (bf16*)(F.ws + WS_XB));
            if (l != NLAYER - 1) SEAM(pb + 8);
        }
    }
#undef IN
#undef SEAM
}

extern "C" void kernel_launch(void* const* d_in, const int* in_sizes, int n_in, void* d_out, int out_size, void* d_ws, size_t ws_size, hipStream_t stream) {
    static int grid = 0;
    if (grid == 0) {
        if (n_in != 23 || in_sizes[0] != TOK * DMODEL || out_size != TOK * DMODEL || ws_size < WS_END) {
            fprintf(stderr, "kernel_launch: unexpected shapes (n_in %d, in0 %d, out %d, ws %zu < %zu); nothing launched\n", n_in, n_in > 0 ? in_sizes[0] : -1, out_size, ws_size, (size_t)WS_END); grid = -1; return; }
        int dev = 0, cus = 0, per_cu = 0;
        if (hipGetDevice(&dev) != hipSuccess || hipDeviceGetAttribute(&cus, hipDeviceAttributeMultiprocessorCount, dev) != hipSuccess) { fprintf(stderr, "kernel_launch: device query failed\n"); grid = -1; return; }
        if (hipFuncSetAttribute((const void*)mega_fwd, hipFuncAttributeMaxDynamicSharedMemorySize, LDS_BYTES) != hipSuccess) { fprintf(stderr, "kernel_launch: hipFuncSetAttribute failed\n"); grid = -1; return; }
        if (hipOccupancyMaxActiveBlocksPerMultiprocessor(&per_cu, (const void*)mega_fwd, NTHR, LDS_BYTES) != hipSuccess || per_cu < 1)
            fprintf(stderr, "kernel_launch: note: occupancy query reports %d workgroups per CU\n", per_cu);
        (void)hipGetLastError();
        grid = cus;
    }
    if (grid < 0) return;
    if (hipMemsetAsync((char*)d_ws + WS_CTL, 0, CTL_ZERO_BYTES, stream) != hipSuccess) { fprintf(stderr, "kernel_launch: memset failed\n"); return; }
    Args a{};
    for (int i = 0; i < 23; ++i) a.in[i] = d_in[i];
    a.out = (float*)d_out; a.ws = (unsigned char*)d_ws;
#if MK_MULTI
    for (int p = 0; p < NPHASE; ++p) { a.ph_lo = p; a.ph_hi = p + 1; hipLaunchKernelGGL(mega_fwd, dim3(grid), dim3(NTHR), LDS_BYTES, stream, a); }
#else
    a.ph_lo = 0; a.ph_hi = NPHASE;
    hipLaunchKernelGGL(mega_fwd, dim3(grid), dim3(NTHR), LDS_BYTES, stream, a);
    if (PROBE_PHASE >= 0) { a.ph_lo = PROBE_PHASE; a.ph_hi = PROBE_PHASE + 1; hipLaunchKernelGGL(mega_fwd, dim3(grid), dim3(NTHR), LDS_BYTES, stream, a); }
#endif
    const hipError_t le = hipPeekAtLastError();
    if (le != hipSuccess) fprintf(stderr, "kernel_launch: launch failed: %s\n", hipGetErrorName(le));
}
```

```cpp
#include <hip/hip_runtime.h>
#include <hip/hip_bf16.h>
#include <cstdio>
#include <cstdint>
#include <cmath>

#ifndef PROBE_PHASE
#define PROBE_PHASE -1
#endif
#ifndef ATTN_EXTRA_QB
#define ATTN_EXTRA_QB -1
#endif
#ifndef REP_ATTN
#define REP_ATTN 1
#endif
#ifndef MK_MULTI
#define MK_MULTI 0
#endif

namespace pg8 {
#define PG8_LAS __attribute__((address_space(3)))
typedef unsigned short bf16_t;
typedef short bf16x8 __attribute__((ext_vector_type(8)));
typedef float f32x4 __attribute__((ext_vector_type(4)));
typedef unsigned u32x4 __attribute__((ext_vector_type(4)));
typedef unsigned u32x2 __attribute__((ext_vector_type(2)));
typedef int i32x4 __attribute__((ext_vector_type(4)));
typedef int i32x8 __attribute__((ext_vector_type(8)));
typedef float f32x8 __attribute__((ext_vector_type(8)));
constexpr int BM = 256, BK = 64, HALF = 128, HTB = HALF * BK * 2, STAGE_BYTES = 8 * HTB, NXCD = 8, WGM = 8;
constexpr int EPI_LDS_OFF = 139264;

__host__ __device__ __forceinline__ int lds_byte(int r, int c) { const int st = (r >> 4) * 2 + (c >> 5), rr = r & 15, cc = c & 31, ob = rr * 64 + cc * 2; return st * 1024 + (ob ^ (((ob >> 9) & 1) << 5)); }
__host__ __device__ __forceinline__ void stage_rc(int b, int& R, int& C) { const int st = b / 1024, sb = b % 1024, swz = sb ^ (((sb >> 9) & 1) << 5); R = (st >> 1) * 16 + swz / 64; C = (st & 1) * 32 + (swz % 64) / 2; }
__host__ __device__ __forceinline__ int perm32(int rho) { const int n = rho >> 4, i = rho & 15; return 8 * (i >> 2) + 4 * n + (i & 3); }

struct Unit { int pm, pn, e, r0, cnt; };
struct Gemm { const bf16_t* A; const bf16_t* Bt; int M, N, K; const bf16_t* A2; const bf16_t* Bt2; int nt1, nt2; };

struct StaticOrder {
    int nM, nN, nwg, G, c;
    __host__ __device__ void init(int M, int N, int G_, int c_) { nM = M / BM; nN = N / BM; nwg = nM * nN; G = G_; c = c_; }
    __host__ __device__ bool next(int i, Unit& u) const {
        const long L = (long)i * G + c; if (L >= nwg) return false;
        int wgid = (int)L; { const int q = nwg / NXCD, r = nwg % NXCD, xcd = wgid % NXCD, off = wgid / NXCD; wgid = (xcd < r ? xcd * (q + 1) : r * (q + 1) + (xcd - r) * q) + off; }
        const int nig = WGM * nN, gid = wgid / nig, fm = gid * WGM, gsz = (nM - fm) < WGM ? (nM - fm) : WGM;
        u.pm = fm + ((wgid % nig) % gsz); u.pn = (wgid % nig) / gsz; u.e = 0; u.r0 = 0; u.cnt = 0; return true;
    }
    __device__ __forceinline__ int tok(const Unit&, int) const { return 0; }
};

struct TableOrder {
    const PG8_LAS int* tab; int n;
    __device__ __forceinline__ bool next(int i, Unit& u) const { if (i >= n) return false; u.pm = __builtin_amdgcn_readfirstlane(tab[i * 8]); u.pn = __builtin_amdgcn_readfirstlane(tab[i * 8 + 1]); u.e = 0; u.r0 = 0; u.cnt = 0; return true; }
    __device__ __forceinline__ int tok(const Unit&, int) const { return 0; }
};
constexpr int TAB_RB_REL = 48;
struct MoeOrder {
    const PG8_LAS int* blk;
    const PG8_LAS int* cnt;
    const int* rowtok;
    int ntl2, G, c, cap;
    __device__ __forceinline__ bool next(int i, Unit& u) const {
        const int L = i * G + c; const int nb = blk[32];
        if (L >= (nb << ntl2)) return false;
        const int rb = L >> ntl2, pn = L & ((1 << ntl2) - 1);
        const int e = blk[TAB_RB_REL + rb];
        u.e = e; u.pm = rb; u.pn = (e << ntl2) + pn; u.r0 = (rb - blk[e]) * 256; u.cnt = cnt[e]; return true;
    }
    __device__ __forceinline__ int tok(const Unit& u, int r) const { const int li = u.r0 + r; const int lc = li < u.cnt ? li : 0; const int t = rowtok[(size_t)u.e * cap + lc]; return li < u.cnt ? t : 0; }
    __device__ __forceinline__ const int* tokptr(const Unit& u, int r) const { const int li = u.r0 + r; const int lc = li < u.cnt ? li : 0; return rowtok + (size_t)u.e * cap + lc; }
    __device__ __forceinline__ int tokfix(const Unit& u, int r, int t) const { return (u.r0 + r) < u.cnt ? t : 0; }
};

__device__ __forceinline__ unsigned cvt_pk_bf16(float lo, float hi) { unsigned r; asm volatile("v_cvt_pk_bf16_f32 %0, %1, %2" : "=v"(r) : "v"(lo), "v"(hi)); return r; }
__device__ __forceinline__ unsigned cvt4_fp8(float a, float b, float c, float d) { int w = 0; w = __builtin_amdgcn_cvt_pk_fp8_f32(a, b, w, false); w = __builtin_amdgcn_cvt_pk_fp8_f32(c, d, w, true); return (unsigned)w; }
__device__ __forceinline__ float bf_lo(unsigned w) { return __uint_as_float(w << 16); }
__device__ __forceinline__ float bf_hi(unsigned w) { return __uint_as_float(w & 0xffff0000u); }

template <class Epi, class Sched, bool ALIGN_EPI = false, bool SP2 = false, bool GATHER = false, bool FP8 = false, bool SEG2 = false>
__device__ __forceinline__ void gemm_phase(PG8_LAS unsigned char* lds, const Gemm g, const Sched& S, const Epi& E) {
    int tid_ = threadIdx.x; asm volatile("" : "+v"(tid_) :: "memory");
    const int tid = tid_, wid = __builtin_amdgcn_readfirstlane(tid >> 6), lane = tid & 63, wr = wid >> 2, wc = wid & 3, fr = lane & 15, fq = lane >> 4;
    const int K = g.K, nt1 = SEG2 ? g.nt1 : 0, nt = SEG2 ? g.nt1 + g.nt2 : K / BK;
    unsigned voffA[2], voffB[2]; int RA[2], CA[2];
#pragma unroll
    for (int i = 0; i < 2; ++i) { int R, C; stage_rc(tid * 16 + i * 8192, R, C); const int Rb = Epi::PERM ? ((R & ~31) + perm32(R & 31)) : R;
        RA[i] = R; CA[i] = C; voffA[i] = (unsigned)(R * K + C) * 2u; voffB[i] = (unsigned)(Rb * K + C) * 2u; }
    const size_t kstep = (size_t)(BK * 2);
    const size_t hstep = (size_t)HALF * K * 2;
    const size_t tstep = 2 * hstep;
    const size_t hstepA = GATHER ? 0 : hstep;
    const unsigned ldsw = (unsigned)wid * 1024u;
    const int aoff = lds_byte(wr * 64 + fr, fq * 8), boff = lds_byte(wc * 32 + fr, fq * 8);
#define PG8_SA(b, h) (((b) * 2 + (h)) * HTB)
#define PG8_SB(b, h) ((4 + (b) * 2 + (h)) * HTB)
#define PG8_STAGE(bufoff, gbase, voff) do { _Pragma("unroll") for (int _i = 0; _i < 2; ++_i) \
        __builtin_amdgcn_global_load_lds((const unsigned*)((const char*)(gbase) + (voff)[_i]), (PG8_LAS unsigned*)(lds + (bufoff) + ldsw + _i * 8192), 16, 0, 0); } while (0)
#define PG8_STAGE_A(bufoff, gbase, h, VO) do { _Pragma("unroll") for (int _i = 0; _i < 2; ++_i) \
        __builtin_amdgcn_global_load_lds((const unsigned*)((const char*)(gbase) + (h) * hstepA + (VO)[h][_i]), (PG8_LAS unsigned*)(lds + (bufoff) + ldsw + _i * 8192), 16, 0, 0); } while (0)
#define PG8_LDA(dst, b, h) do { _Pragma("unroll") for (int m = 0; m < 4; ++m) { if constexpr (FP8) { const i32x4 _lo = *(const PG8_LAS i32x4*)(lds + PG8_SA(b, h) + aoff + m * 2048), _hi = *(const PG8_LAS i32x4*)(lds + PG8_SA(b, h) + aoff + m * 2048 + 1024); \
            dst##8[m] = __builtin_shufflevector(_lo, _hi, 0, 1, 2, 3, 4, 5, 6, 7); } else { _Pragma("unroll") for (int k = 0; k < 2; ++k) dst[m][k] = *(const PG8_LAS bf16x8*)(lds + PG8_SA(b, h) + aoff + m * 2048 + k * 1024); } } } while (0)
#define PG8_LDB(dst, b, h) do { _Pragma("unroll") for (int n = 0; n < 2; ++n) { if constexpr (FP8) { const i32x4 _lo = *(const PG8_LAS i32x4*)(lds + PG8_SB(b, h) + boff + n * 2048), _hi = *(const PG8_LAS i32x4*)(lds + PG8_SB(b, h) + boff + n * 2048 + 1024); \
            dst##8[n] = __builtin_shufflevector(_lo, _hi, 0, 1, 2, 3, 4, 5, 6, 7); } else { _Pragma("unroll") for (int k = 0; k < 2; ++k) dst[n][k] = *(const PG8_LAS bf16x8*)(lds + PG8_SB(b, h) + boff + n * 2048 + k * 1024); } } } while (0)
#define PG8_MMA(ai, bj, At, Bt) do { __builtin_amdgcn_s_setprio(1); _Pragma("unroll") for (int m = 0; m < 4; ++m) _Pragma("unroll") for (int n = 0; n < 2; ++n) { \
        if constexpr (FP8) asm volatile("v_mfma_scale_f32_16x16x128_f8f6f4 %0, %1, %2, %0, %3, %3 op_sel_hi:[0,0,0]" : "+v"(acc[ai][bj][m][n]) : "v"(Bt##8[n]), "v"(At##8[m]), "v"(fp8_one)); \
        else { _Pragma("unroll") for (int k = 0; k < 2; ++k) acc[ai][bj][m][n] = __builtin_amdgcn_mfma_f32_16x16x32_bf16(Bt[n][k], At[m][k], acc[ai][bj][m][n], 0, 0, 0); } } \
        __builtin_amdgcn_s_setprio(0); } while (0)
#define PG8_WAIT_V(n) asm volatile("s_waitcnt vmcnt(" #n ")" ::: "memory")
#define PG8_WAIT_L(n) asm volatile("s_waitcnt lgkmcnt(" #n ")" ::: "memory")
#define PG8_BAR __builtin_amdgcn_s_barrier()
#define PG8_SCHED __builtin_amdgcn_sched_barrier(0)
#define PG8_GOFF(dst, unit) do { if constexpr (GATHER) { int _tk[2][2];     \
        { const int* _p0 = S.tokptr(unit, RA[0]); const int* _p1 = S.tokptr(unit, RA[1]); const int* _p2 = S.tokptr(unit, HALF + RA[0]); const int* _p3 = S.tokptr(unit, HALF + RA[1]); \
          asm volatile("global_load_dword %0, %4, off\n\tglobal_load_dword %1, %5, off\n\tglobal_load_dword %2, %6, off\n\tglobal_load_dword %3, %7, off\n\ts_waitcnt vmcnt(0)" \
                       : "=&v"(_tk[0][0]), "=&v"(_tk[0][1]), "=&v"(_tk[1][0]), "=&v"(_tk[1][1]) : "v"(_p0), "v"(_p1), "v"(_p2), "v"(_p3) : "memory"); } \
        _Pragma("unroll") for (int _h = 0; _h < 2; ++_h) _Pragma("unroll") for (int _i = 0; _i < 2; ++_i) { const int _t = S.tokfix(unit, _h * HALF + RA[_i], _tk[_h][_i]); dst[_h][_i] = (unsigned)(_t * K + CA[_i]) * 2u; } \
      } else { _Pragma("unroll") for (int _h = 0; _h < 2; ++_h) _Pragma("unroll") for (int _i = 0; _i < 2; ++_i) dst[_h][_i] = voffA[_i]; } } while (0)
    Unit cur, nxt; int ui = 0;
    if (!S.next(0, cur)) return;
    f32x4 acc[2][2][4][2];
#pragma unroll
    for (int a = 0; a < 2; ++a)
#pragma unroll
        for (int b = 0; b < 2; ++b)
#pragma unroll
            for (int m = 0; m < 4; ++m)
#pragma unroll
                for (int n = 0; n < 2; ++n) acc[a][b][m][n] = (f32x4){0.f, 0.f, 0.f, 0.f};
    bf16x8 At[4][2], B0[2][2], B1[2][2]; i32x8 At8[4], B08[2], B18[2];
    const int fp8_one = 0x7F7F7F7F;
    unsigned voc[2][2], von[2][2];
    PG8_GOFF(voc, cur);
    const char* cA = GATHER ? (const char*)g.A : (const char*)g.A + (size_t)cur.pm * tstep; const char* cB = (const char*)g.Bt + (size_t)cur.pn * tstep;
    const char* cA2 = SEG2 ? (const char*)g.A2 + (size_t)cur.pm * tstep - (size_t)nt1 * kstep : cA; const char* cB2 = SEG2 ? (const char*)g.Bt2 + (size_t)cur.pn * tstep - (size_t)nt1 * kstep : cB;
    static_assert(SP2, "only the SP2 loop is kept in this file");
    PG8_STAGE(PG8_SB(0, 0), cB, voffB); PG8_STAGE(PG8_SB(0, 1), cB + hstep, voffB); PG8_STAGE_A(PG8_SA(0, 0), cA, 0, voc); PG8_STAGE_A(PG8_SA(0, 1), cA, 1, voc);
    if (wr == 1) PG8_BAR;
    PG8_WAIT_V(2); PG8_BAR;
    PG8_STAGE(PG8_SB(1, 0), cB + kstep, voffB); PG8_STAGE_A(PG8_SA(1, 0), cA + kstep, 0, voc); PG8_STAGE(PG8_SB(1, 1), cB + hstep + kstep, voffB);
    PG8_WAIT_V(6); PG8_BAR;
    for (;;) {
        const bool has_next = S.next(ui + 1, nxt);
        const char* nA = GATHER ? (const char*)g.A : (has_next ? (const char*)g.A + (size_t)nxt.pm * tstep : cA);
        const char* nB = has_next ? (const char*)g.Bt + (size_t)nxt.pn * tstep : cB;
        if constexpr (Epi::LDSC) E.stage(cur, lds + EPI_LDS_OFF + (ui & 1) * 8192, wid, lane);
        if constexpr (GATHER) { if (has_next) { PG8_GOFF(von, nxt); } else {
#pragma unroll
            for (int h = 0; h < 2; ++h)
#pragma unroll
                for (int i = 0; i < 2; ++i) von[h][i] = voc[h][i]; } }
#pragma unroll 1
        for (int t = 0; t < nt; t += 2) {
            const bool last = (t == nt - 2);
            if constexpr (SEG2) { if (t == nt1) { int lm_ = lane; asm volatile("" : "+v"(lm_)); E.mid(acc, cur, wr, wc, lm_ & 15, lm_ >> 4, nullptr); } }
            const char* sA = (SEG2 && t >= nt1) ? cA2 : cA; const char* tA = (SEG2 && t + 2 >= nt1) ? cA2 : cA; const char* tB = (SEG2 && t + 2 >= nt1) ? cB2 : cB;
            const char* a1 = sA + (size_t)(t + 1) * kstep;
            const char* a2 = last ? nA : tA + (size_t)(t + 2) * kstep; const char* b2 = last ? nB : tB + (size_t)(t + 2) * kstep;
            const char* a3 = a2 + kstep; const char* b3 = b2 + kstep;
            unsigned vo2[2][2];
#pragma unroll
            for (int h = 0; h < 2; ++h)
#pragma unroll
                for (int i = 0; i < 2; ++i) { if constexpr (GATHER) vo2[h][i] = last ? von[h][i] : voc[h][i]; else vo2[h][i] = voffA[i]; }
            PG8_LDB(B0, 0, 0); PG8_LDB(B1, 0, 1); PG8_SCHED; PG8_LDA(At, 0, 0); PG8_STAGE_A(PG8_SA(1, 1), a1, 1, voc);
            PG8_WAIT_V(8); PG8_WAIT_L(0); PG8_BAR; PG8_MMA(0, 0, At, B0); PG8_MMA(0, 1, At, B1); PG8_BAR; PG8_SCHED;
            PG8_LDA(At, 0, 1); PG8_STAGE(PG8_SB(0, 0), b2, voffB); PG8_STAGE(PG8_SB(0, 1), b2 + hstep, voffB); PG8_STAGE_A(PG8_SA(0, 0), a2, 0, vo2);
            PG8_WAIT_V(8); PG8_WAIT_L(0); PG8_BAR; PG8_MMA(1, 0, At, B0); PG8_MMA(1, 1, At, B1); PG8_BAR; PG8_SCHED;
            PG8_LDB(B0, 1, 0); PG8_LDB(B1, 1, 1); PG8_SCHED; PG8_LDA(At, 1, 0); PG8_STAGE_A(PG8_SA(0, 1), a2, 1, vo2);
            PG8_WAIT_V(8); PG8_WAIT_L(0); PG8_BAR; PG8_MMA(0, 0, At, B0); PG8_MMA(0, 1, At, B1); PG8_BAR; PG8_SCHED;
            PG8_LDA(At, 1, 1); PG8_STAGE(PG8_SB(1, 0), b3, voffB); PG8_STAGE(PG8_SB(1, 1), b3 + hstep, voffB); PG8_STAGE_A(PG8_SA(1, 0), a3, 0, vo2);
            PG8_WAIT_V(8); PG8_WAIT_L(0); PG8_BAR; PG8_MMA(1, 0, At, B0); PG8_MMA(1, 1, At, B1); PG8_BAR; PG8_SCHED;
        }
        if constexpr (ALIGN_EPI) { if (wr == 0) PG8_BAR; }
        { int ln_ = lane; asm volatile("" : "+v"(ln_));
          if constexpr (FP8) asm volatile("s_nop 15\n\ts_nop 7" ::: "memory");
          E(acc, cur, wr, wc, ln_ & 15, ln_ >> 4, lds + EPI_LDS_OFF + (ui & 1) * 8192); }
        if (!has_next) break;
#pragma unroll
        for (int a = 0; a < 2; ++a)
#pragma unroll
            for (int b = 0; b < 2; ++b)
#pragma unroll
                for (int m = 0; m < 4; ++m)
#pragma unroll
                    for (int n = 0; n < 2; ++n) acc[a][b][m][n] = (f32x4){0.f, 0.f, 0.f, 0.f};
        cur = nxt; cA = nA; cB = nB; ++ui;
        if constexpr (SEG2) { cA2 = (const char*)g.A2 + (size_t)cur.pm * tstep - (size_t)nt1 * kstep; cB2 = (const char*)g.Bt2 + (size_t)cur.pn * tstep - (size_t)nt1 * kstep; }
        if constexpr (GATHER) {
#pragma unroll
            for (int h = 0; h < 2; ++h)
#pragma unroll
                for (int i = 0; i < 2; ++i) voc[h][i] = von[h][i]; }
        if constexpr (ALIGN_EPI) { if (wr == 1) PG8_BAR; }
    }
    PG8_WAIT_V(0);
    if constexpr (!ALIGN_EPI) { if (wr == 0) PG8_BAR; }
    PG8_BAR;
#undef PG8_SA
#undef PG8_SB
#undef PG8_STAGE
#undef PG8_STAGE_A
#undef PG8_LDA
#undef PG8_LDB
#undef PG8_MMA
#undef PG8_WAIT_V
#undef PG8_WAIT_L
#undef PG8_BAR
#undef PG8_SCHED
#undef PG8_GOFF
}
}

namespace attn_body {
using bf16=__hip_bfloat16;
using bf16x8=__attribute__((ext_vector_type(8)))short;
using s16x4=__attribute__((ext_vector_type(4)))short;
using f32x16=__attribute__((ext_vector_type(16)))float;
using u32x4=__attribute__((ext_vector_type(4)))unsigned;
using f32x4_t=__attribute__((ext_vector_type(4)))float;
constexpr int SEQ=2048,D=64,DM=1024;
constexpr int NW=8,QBLK=32,QB=QBLK*NW,KVBLK=64,NQB=SEQ/QB;
__device__ __forceinline__ int crow(int r,int hi){return (r&3)+8*(r>>2)+4*hi;}
#define SBAR() __builtin_amdgcn_sched_barrier(0)
__device__ __forceinline__ void cmask(f32x16&p0,f32x16&p1,int jb,int qrel,int hi){
  const float NEG=-INFINITY; int kb=64*jb+4*hi;
  #pragma unroll
  for(int r=0;r<16;++r){int kv=kb+(r&3)+8*(r>>2); if(kv>qrel)p0[r]=NEG; if(kv+32>qrel)p1[r]=NEG;}
}
constexpr int NSLOT=3, SLOTB=8192;
constexpr int LDS_K=0, LDS_V=NSLOT*SLOTB, LDS_WS=2*NSLOT*SLOTB, LDS_OST=LDS_WS+NW*64*4, LDS_BYTES=LDS_OST+NW*4096;
constexpr float C2=0.125f*1.4426950408889634f;
__device__ __forceinline__ void glds16(const void*gsrc,unsigned lds_dst){unsigned keep;
  asm volatile("s_mov_b32 %0, m0\n\ts_mov_b32 m0, %2\n\ts_nop 0\n\tglobal_load_lds_dwordx4 %1, off\n\ts_mov_b32 m0, %0":"=&s"(keep):"v"(gsrc),"s"(lds_dst):"memory");}
__device__ __forceinline__ float max3f(float a,float b,float c){float r;asm("v_max3_f32 %0, %1, %2, %3":"=v"(r):"v"(a),"v"(b),"v"(c));return r;}
__device__ __forceinline__ float max2f(float a,float b){float r;asm("v_max_f32_e32 %0, %1, %2":"=v"(r):"v"(a),"v"(b));return r;}
__device__ __forceinline__ float fadd_s(float a,float b){float r;asm("v_add_f32_e32 %0, %1, %2":"=v"(r):"v"(a),"v"(b));return r;}
__device__ __forceinline__ float fsub_s(float a,float b){float r;asm("v_sub_f32_e32 %0, %1, %2":"=v"(r):"v"(a),"v"(b));return r;}
typedef float f32x2_t __attribute__((ext_vector_type(2))); typedef __bf16 bf16x2_t __attribute__((ext_vector_type(2)));
__device__ __forceinline__ unsigned cvtpk_s(float lo,float hi){f32x2_t v={lo,hi};bf16x2_t b=__builtin_convertvector(v,bf16x2_t);return __builtin_bit_cast(unsigned,b);}
#define WAIT_BAR(N) asm volatile("s_waitcnt vmcnt(" #N ") lgkmcnt(0)\n\ts_barrier":::"memory")

__device__ __forceinline__ void qkt(f32x16&p0,f32x16&p1,const char*Kslot,const bf16x8*qr,const f32x16&negm,int r32,int hi){
  const char*kb=Kslot+hi*1024+r32*16;
  #pragma unroll
  for(int d0=0;d0<4;++d0){
    const bf16x8 b0=*reinterpret_cast<const bf16x8*>(kb+d0*2048);
    const bf16x8 b1=*reinterpret_cast<const bf16x8*>(kb+d0*2048+512);
    if(d0==0){p0=__builtin_amdgcn_mfma_f32_32x32x16_bf16(b0,qr[0],negm,0,0,0);p1=__builtin_amdgcn_mfma_f32_32x32x16_bf16(b1,qr[0],negm,0,0,0);}
    else{p0=__builtin_amdgcn_mfma_f32_32x32x16_bf16(b0,qr[d0],p0,0,0,0);p1=__builtin_amdgcn_mfma_f32_32x32x16_bf16(b1,qr[d0],p1,0,0,0);}}
}
typedef __attribute__((address_space(3))) const char* lds_cptr;
typedef short v4i16_t __attribute__((ext_vector_type(4)));
__device__ __forceinline__ void kload8(bf16x8*kf,lds_cptr kp){
  kf[0]=*(const __attribute__((address_space(3))) bf16x8*)(kp);      kf[1]=*(const __attribute__((address_space(3))) bf16x8*)(kp+512);
  kf[2]=*(const __attribute__((address_space(3))) bf16x8*)(kp+2048); kf[3]=*(const __attribute__((address_space(3))) bf16x8*)(kp+2560);
  kf[4]=*(const __attribute__((address_space(3))) bf16x8*)(kp+4096); kf[5]=*(const __attribute__((address_space(3))) bf16x8*)(kp+4608);
  kf[6]=*(const __attribute__((address_space(3))) bf16x8*)(kp+6144); kf[7]=*(const __attribute__((address_space(3))) bf16x8*)(kp+6656);
}
__device__ __forceinline__ void kload2(bf16x8*kf,lds_cptr kp,int j){ kf[2*j]=*(const __attribute__((address_space(3))) bf16x8*)(kp+j*2048); kf[2*j+1]=*(const __attribute__((address_space(3))) bf16x8*)(kp+j*2048+512); }
__device__ __forceinline__ s16x4 vtr(lds_cptr p){ return __builtin_bit_cast(s16x4,__builtin_amdgcn_ds_read_tr16_b64_v4i16((__attribute__((address_space(3))) v4i16_t*)p)); }
__device__ __forceinline__ float rowmax(const f32x16&p0,const f32x16&p1){
  float a=max3f(p0[0],p0[1],p1[0]),b=max3f(p0[2],p0[3],p1[1]);a=max3f(a,p1[2],p1[3]);
  #pragma unroll
  for(int r=4;r<16;r+=4){a=max3f(a,p0[r],p0[r+1]);b=max3f(b,p0[r+2],p0[r+3]);a=max3f(a,p1[r],p1[r+1]);b=max3f(b,p1[r+2],p1[r+3]);}
  const float m=max2f(a,b);
  auto rr=__builtin_amdgcn_permlane32_swap(__float_as_uint(m),__float_as_uint(m),false,false);
  return max2f(__uint_as_float(rr[0]),__uint_as_float(rr[1]));
}
constexpr int ATTN_LDS_BYTES=LDS_BYTES;
constexpr int V2_SLOTV=16384, V2_NSV=4, V2_LDS_K=0, V2_LDS_V=NSLOT*SLOTB, V2_LDS_WS=V2_LDS_V+V2_NSV*V2_SLOTV, V2_LDS_OST=V2_LDS_WS+NW*64*4, V2_LDS_BYTES=V2_LDS_OST+NW*4096;
template<int CTRL> __device__ __forceinline__ float dppf(float v){ return __builtin_bit_cast(float,__builtin_amdgcn_update_dpp(0,__builtin_bit_cast(int,v),CTRL,0xf,0xf,true)); }
struct PrimeNext { long rowbase; const bf16* K; const bf16* V; int on; };
__device__ __forceinline__ void attn_prime(long rowbase,const bf16*K,const bf16*V,char*shm){
  int tid_=threadIdx.x; asm volatile("":"+v"(tid_)::"memory");
  const int lane=tid_&63; const int wid=__builtin_amdgcn_readfirstlane(tid_>>6);
  const unsigned lds0=(unsigned)(uintptr_t)shm;
  const bf16*ksrc=K+rowbase*DM+(long)lane*DM+wid*8;
  const bf16*vsrc=V+rowbase*DM+(long)(16*(wid&3)+(lane>>2))*DM+(wid>>2)*32+(lane&3)*8;
  const unsigned kdst=lds0+V2_LDS_K+wid*1024, vdst=lds0+V2_LDS_V+wid*1024;
  glds16(ksrc,(unsigned)__builtin_amdgcn_readfirstlane(kdst));
  glds16(vsrc,(unsigned)__builtin_amdgcn_readfirstlane(vdst)); glds16(vsrc+64,(unsigned)__builtin_amdgcn_readfirstlane(vdst+8192));
  glds16(ksrc+(long)KVBLK*DM,(unsigned)__builtin_amdgcn_readfirstlane(kdst+SLOTB));
  glds16(ksrc+(long)2*KVBLK*DM,(unsigned)__builtin_amdgcn_readfirstlane(kdst+2*SLOTB));
  glds16(vsrc+(long)KVBLK*DM,(unsigned)__builtin_amdgcn_readfirstlane(vdst+V2_SLOTV)); glds16(vsrc+(long)KVBLK*DM+64,(unsigned)__builtin_amdgcn_readfirstlane(vdst+V2_SLOTV+8192));
  glds16(vsrc+(long)2*KVBLK*DM,(unsigned)__builtin_amdgcn_readfirstlane(vdst+2*V2_SLOTV)); glds16(vsrc+(long)2*KVBLK*DM+64,(unsigned)__builtin_amdgcn_readfirstlane(vdst+2*V2_SLOTV+8192));
}
template<int THRL> __device__ __forceinline__ void attn_pass2(long rowbase,int qb,const bf16*Q,const bf16*__restrict__ K,const bf16*__restrict__ V,char*shm,f32x16 (&o)[4],const PrimeNext nx){
  int tid_=threadIdx.x; asm volatile("":"+v"(tid_)::"memory");
  const int tid=tid_,lane=tid&63,r32=lane&31,hi=lane>>5; const int wid=__builtin_amdgcn_readfirstlane(tid>>6);
  const int q0=qb*QB;
  const bf16*Qw=Q+(rowbase+q0+wid*QBLK)*DM;
  const bf16*Kh=K+rowbase*DM,*Vh=V+rowbase*DM;
  const unsigned lds0=(unsigned)(uintptr_t)shm;
  float*wsf=(float*)(shm+V2_LDS_WS)+wid*64;
  const bf16*ksrc=Kh+(long)lane*DM+wid*8;
  const bf16*vsrc=Vh+(long)(16*(wid&3)+(lane>>2))*DM+(wid>>2)*32+(lane&3)*8;
  const unsigned kdst=lds0+V2_LDS_K+wid*1024, vdst=lds0+V2_LDS_V+wid*1024;
  #define DMA_K(t,slot) glds16(ksrc+(long)(t)*KVBLK*DM,(unsigned)__builtin_amdgcn_readfirstlane(kdst+(slot)))
  #define DMA_V(t,slot) do{ glds16(vsrc+(long)(t)*KVBLK*DM,(unsigned)__builtin_amdgcn_readfirstlane(vdst+(slot))); glds16(vsrc+(long)(t)*KVBLK*DM+64,(unsigned)__builtin_amdgcn_readfirstlane(vdst+(slot)+8192)); }while(0)
  const int vb0=(int)(lds0+V2_LDS_V)+((lane>>4)&1)*32+(lane&3)*8+(4*hi+((lane&15)>>2))*64;
  const char*Kbase=shm+V2_LDS_K; bf16x8 kf[8];
  const lds_cptr shm3=(lds_cptr)shm; const lds_cptr kp0=shm3+V2_LDS_K+hi*1024+r32*16; const lds_cptr vp0=shm3+V2_LDS_V+((lane>>4)&1)*32+(lane&3)*8+(4*hi+((lane&15)>>2))*64;
  const int NT=(q0+QB)/KVBLK;
  bf16x8 qr[4];
  #pragma unroll
  for(int d0=0;d0<4;++d0)qr[d0]=*reinterpret_cast<const bf16x8*>(&Qw[(long)r32*DM+d0*16+hi*8]);
  float mhat=0.f,l_reg=0.f; o[0]=f32x16{};o[1]=f32x16{};o[2]=f32x16{};o[3]=f32x16{};
  const f32x16 zero16=f32x16{}; f32x16 negm;
  const int qrel=wid*QBLK+r32;
  #define CMASK(P0,P1,t) do{int jb_=(t)-(NT-4); if(jb_>=0)cmask(P0,P1,jb_,qrel,hi);}while(0)
  bool resc=false;
  #define RESC() do{ if(resc){ asm volatile("s_waitcnt lgkmcnt(0)":::"memory"); \
      _Pragma("unroll") for(int d_=0;d_<4;++d_) _Pragma("unroll") for(int r=0;r<16;++r)o[d_][r]*=wsf[crow(r,hi)]; } }while(0)
  f32x16 C0,C1;
  u32x4 pw0,pw1,pw2,pw3;
  int sk_prev=0,sk_cur=0,sk_next=SLOTB, sv_prev=0,sv_cur=0,sv_tgt=2*V2_SLOTV;
  #define ROT() do{sk_prev=sk_cur;sk_cur=sk_next;sk_next=(sk_next==(NSLOT-1)*SLOTB)?0:sk_next+SLOTB; sv_prev=sv_cur;sv_cur=(sv_cur==(V2_NSV-1)*V2_SLOTV)?0:sv_cur+V2_SLOTV;sv_tgt=(sv_tgt==(V2_NSV-1)*V2_SLOTV)?0:sv_tgt+V2_SLOTV;}while(0)
  #define PKW(P,B) cvtpk_s(P[B],P[B+1])
  #define PAF(k) __builtin_bit_cast(bf16x8,pw##k)
  WAIT_BAR(0);
  { qkt(C0,C1,Kbase,qr,zero16,r32,hi); asm volatile("s_nop 15\n\ts_nop 7":"+v"(C0),"+v"(C1)); CMASK(C0,C1,0);
    const float rm=rowmax(C0,C1); mhat=rm; float sacc=0.f;
    _Pragma("unroll") for(int r=0;r<16;++r)negm[r]=-mhat; asm volatile("":"+v"(negm));
    _Pragma("unroll") for(int r=0;r<16;++r){C0[r]=__builtin_amdgcn_exp2f(C0[r]-mhat);C1[r]=__builtin_amdgcn_exp2f(C1[r]-mhat);sacc+=C0[r];sacc+=C1[r];}
    l_reg=sacc;
    pw0=(u32x4){PKW(C0,0),PKW(C0,2),PKW(C0,4),PKW(C0,6)};pw1=(u32x4){PKW(C0,8),PKW(C0,10),PKW(C0,12),PKW(C0,14)};pw2=(u32x4){PKW(C1,0),PKW(C1,2),PKW(C1,4),PKW(C1,6)};pw3=(u32x4){PKW(C1,8),PKW(C1,10),PKW(C1,12),PKW(C1,14)}; }
  WAIT_BAR(0);
  DMA_K(3,0);
  ROT();
  kload8(kf,kp0+sk_cur);
  WAIT_BAR(1);
  s16x4 vlo[4],vhi[4];
  #define VFR(i) (bf16x8){vlo[i][0],vlo[i][1],vlo[i][2],vlo[i][3],vhi[i][0],vhi[i][1],vhi[i][2],vhi[i][3]}
  #define PIN(x) asm volatile("":"+v"(x))
  #define MX3(a,b,c) __builtin_fmaxf(__builtin_fmaxf((a),(b)),(c))
  #define EXS(v) __builtin_amdgcn_exp2f((v)-mhat)
  #define GAPB(MF,XS,BS,XE,BE,XA,BA,EXTRA) do{ MF; XE[BE]=__builtin_amdgcn_exp2f(XE[BE]); XE[(BE)+1]=__builtin_amdgcn_exp2f(XE[(BE)+1]); \
      sacc0+=XA[BA]; sacc1+=XA[(BA)+1]; PIN(XE); PIN(sacc0); PIN(sacc1); EXTRA; SBAR(); }while(0)
  #define VRD(i,d,ks) do{ vlo[i]=vtr(vp_+((d)*4096+(ks)*1024)); vhi[i]=vtr(vp_+((d)*4096+(ks)*1024+512)); }while(0)
  #define KRD1(G,j) do{ if(G){ kf[j]=*(const __attribute__((address_space(3))) bf16x8*)(kp0+sk_next+((j)>>1)*2048+((j)&1)*512); SBAR(); } }while(0)
  #define QKG(MF) do{ MF; SBAR(); }while(0)
  #define STEP(t,GK,GV,GL) do{ SBAR(); \
    const lds_cptr vp_=vp0+sv_prev; \
    VRD(0,0,0); SBAR(); QKG(C0=__builtin_amdgcn_mfma_f32_32x32x16_bf16(kf[0],qr[0],negm,0,0,0)); \
    VRD(1,1,0); SBAR(); QKG(C1=__builtin_amdgcn_mfma_f32_32x32x16_bf16(kf[1],qr[0],negm,0,0,0)); \
    VRD(2,2,0); SBAR(); QKG(C0=__builtin_amdgcn_mfma_f32_32x32x16_bf16(kf[2],qr[1],C0,0,0,0)); \
    VRD(3,3,0); SBAR(); QKG(C1=__builtin_amdgcn_mfma_f32_32x32x16_bf16(kf[3],qr[1],C1,0,0,0)); \
    QKG(C0=__builtin_amdgcn_mfma_f32_32x32x16_bf16(kf[4],qr[2],C0,0,0,0)); \
    QKG(C1=__builtin_amdgcn_mfma_f32_32x32x16_bf16(kf[5],qr[2],C1,0,0,0)); \
    QKG(C0=__builtin_amdgcn_mfma_f32_32x32x16_bf16(kf[6],qr[3],C0,0,0,0)); \
    QKG(C1=__builtin_amdgcn_mfma_f32_32x32x16_bf16(kf[7],qr[3],C1,0,0,0)); \
    if(GK){DMA_K((t)+3,sk_cur);} if(GV){DMA_V((t)+2,sv_tgt);} \
    CMASK(C0,C1,t); \
    { float a=MX3(C0[0],C0[1],C1[0]),b=MX3(C0[2],C0[3],C1[1]); a=MX3(a,C1[2],C1[3]); \
      _Pragma("unroll") for(int r=4;r<16;r+=4){a=MX3(a,C0[r],C0[r+1]);b=MX3(b,C0[r+2],C0[r+3]);a=MX3(a,C1[r],C1[r+1]);b=MX3(b,C1[r+2],C1[r+3]);} \
      float rm=__builtin_fmaxf(a,b); { auto rr=__builtin_amdgcn_permlane32_swap(__float_as_uint(rm),__float_as_uint(rm),false,false); rm=__builtin_fmaxf(__uint_as_float(rr[0]),__uint_as_float(rr[1])); } \
      resc=false; \
      if(__builtin_expect(__any(rm>(float)THRL),0)){ const float dl=__builtin_fmaxf(rm,0.f); mhat+=dl; \
        _Pragma("unroll") for(int r=0;r<16;++r){C0[r]-=dl;C1[r]-=dl;} \
        _Pragma("unroll") for(int r=0;r<16;++r)negm[r]=-mhat; asm volatile("":"+v"(negm)); \
        const float f=__builtin_amdgcn_exp2f(-dl); l_reg*=f; if(hi==0)wsf[r32]=f; resc=true; } } \
    float sacc0=0.f,sacc1=0.f; \
    SBAR(); \
    { o[0]=__builtin_amdgcn_mfma_f32_32x32x16_bf16(PAF(0),VFR(0),o[0],0,0,0); C0[0]=__builtin_amdgcn_exp2f(C0[0]); C0[1]=__builtin_amdgcn_exp2f(C0[1]); PIN(C0); SBAR(); } VRD(0,0,1); SBAR(); \
    GAPB(o[1]=__builtin_amdgcn_mfma_f32_32x32x16_bf16(PAF(0),VFR(1),o[1],0,0,0), C0,4,  C0,2,  C0,0,  (void)0);  VRD(1,1,1); SBAR(); \
    GAPB(o[2]=__builtin_amdgcn_mfma_f32_32x32x16_bf16(PAF(0),VFR(2),o[2],0,0,0), C0,6,  C0,4,  C0,2,  (void)0);  VRD(2,2,1); SBAR(); \
    GAPB(o[3]=__builtin_amdgcn_mfma_f32_32x32x16_bf16(PAF(0),VFR(3),o[3],0,0,0), C0,8,  C0,6,  C0,4,  (void)0);  VRD(3,3,1); SBAR(); \
    GAPB(o[0]=__builtin_amdgcn_mfma_f32_32x32x16_bf16(PAF(1),VFR(0),o[0],0,0,0), C0,10, C0,8,  C0,6,  pw0[0]=PKW(C0,0); pw0[1]=PKW(C0,2); PIN(pw0));  VRD(0,0,2); SBAR(); \
    GAPB(o[1]=__builtin_amdgcn_mfma_f32_32x32x16_bf16(PAF(1),VFR(1),o[1],0,0,0), C0,12, C0,10, C0,8,  pw0[2]=PKW(C0,4); pw0[3]=PKW(C0,6); PIN(pw0));  VRD(1,1,2); SBAR(); \
    GAPB(o[2]=__builtin_amdgcn_mfma_f32_32x32x16_bf16(PAF(1),VFR(2),o[2],0,0,0), C0,14, C0,12, C0,10, (void)0); VRD(2,2,2); SBAR(); \
    GAPB(o[3]=__builtin_amdgcn_mfma_f32_32x32x16_bf16(PAF(1),VFR(3),o[3],0,0,0), C1,0,  C0,14, C0,12, (void)0); VRD(3,3,2); SBAR(); \
    KRD1(GL,0); GAPB(o[0]=__builtin_amdgcn_mfma_f32_32x32x16_bf16(PAF(2),VFR(0),o[0],0,0,0), C1,2,  C1,0,  C0,14, pw1[0]=PKW(C0,8);  pw1[1]=PKW(C0,10); PIN(pw1));  VRD(0,0,3); SBAR(); \
    KRD1(GL,1); GAPB(o[1]=__builtin_amdgcn_mfma_f32_32x32x16_bf16(PAF(2),VFR(1),o[1],0,0,0), C1,4,  C1,2,  C1,0,  pw1[2]=PKW(C0,12); pw1[3]=PKW(C0,14); PIN(pw1));  VRD(1,1,3); SBAR(); \
    KRD1(GL,2); GAPB(o[2]=__builtin_amdgcn_mfma_f32_32x32x16_bf16(PAF(2),VFR(2),o[2],0,0,0), C1,6,  C1,4,  C1,2,  (void)0);  VRD(2,2,3); SBAR(); \
    KRD1(GL,3); GAPB(o[3]=__builtin_amdgcn_mfma_f32_32x32x16_bf16(PAF(2),VFR(3),o[3],0,0,0), C1,8,  C1,6,  C1,4,  (void)0);  VRD(3,3,3); SBAR(); \
    KRD1(GL,4); GAPB(o[0]=__builtin_amdgcn_mfma_f32_32x32x16_bf16(PAF(3),VFR(0),o[0],0,0,0), C1,10, C1,8,  C1,6,  pw2[0]=PKW(C1,0); pw2[1]=PKW(C1,2); PIN(pw2)); \
    KRD1(GL,5); GAPB(o[1]=__builtin_amdgcn_mfma_f32_32x32x16_bf16(PAF(3),VFR(1),o[1],0,0,0), C1,12, C1,10, C1,8,  pw2[2]=PKW(C1,4); pw2[3]=PKW(C1,6); PIN(pw2)); \
    KRD1(GL,6); GAPB(o[2]=__builtin_amdgcn_mfma_f32_32x32x16_bf16(PAF(3),VFR(2),o[2],0,0,0), C1,14, C1,12, C1,10, (void)0); \
    KRD1(GL,7); { o[3]=__builtin_amdgcn_mfma_f32_32x32x16_bf16(PAF(3),VFR(3),o[3],0,0,0); C1[14]=__builtin_amdgcn_exp2f(C1[14]); C1[15]=__builtin_amdgcn_exp2f(C1[15]); sacc0+=C1[12]; sacc1+=C1[13]; PIN(C1); PIN(sacc0); PIN(sacc1); \
      pw3[0]=PKW(C1,8); pw3[1]=PKW(C1,10); pw3[2]=PKW(C1,12); PIN(pw3); SBAR(); } \
    pw3[3]=PKW(C1,14); sacc0+=C1[14]; sacc1+=C1[15]; \
    l_reg+=sacc0+sacc1; \
    }while(0)
  int t=1;
  #undef CMASK
  #define CMASK(P0,P1,t) do{}while(0)
  #define ENDW(tt) do{ const int n_=((tt)+2>=NT)?0:((((tt)>1)?2:0)+(((tt)+3<NT)?1:0)+(((tt)+2<NT)?2:0)); \
      if(n_==5){WAIT_BAR(5);} else if(n_==4){WAIT_BAR(4);} else if(n_==3){WAIT_BAR(3);} else if(n_==2){WAIT_BAR(2);} else {WAIT_BAR(0);} }while(0)
  for(;t+4<NT;++t){ STEP(t,true,true,true); if(t==1){WAIT_BAR(3);} else {WAIT_BAR(5);} RESC(); ROT(); }
  #undef CMASK
  #define CMASK(P0,P1,t) do{int jb_=(t)-(NT-4); if(jb_>=0)cmask(P0,P1,jb_,qrel,hi);}while(0)
  for(;t+1<NT;++t){ STEP(t,(t+3<NT),(t+2<NT),(t+1<NT)); ENDW(t); RESC(); ROT(); }
  STEP(NT-1,false,false,false); RESC();
  { SBAR(); const int vb=vb0+sv_cur;
    #pragma unroll
    for(int d0=0;d0<4;++d0){s16x4 lo[4],hh[4];
      #pragma unroll
      for(int ks=0;ks<4;++ks){
        asm volatile("ds_read_b64_tr_b16 %0,%1 offset:%c2":"=&v"(lo[ks]):"v"(vb),"i"(d0*4096+ks*1024):"memory");
        asm volatile("ds_read_b64_tr_b16 %0,%1 offset:%c2":"=&v"(hh[ks]):"v"(vb),"i"(d0*4096+ks*1024+512):"memory");}
      asm volatile("s_waitcnt lgkmcnt(0)":::"memory");SBAR();
      #define PK(k) (bf16x8){lo[k][0],lo[k][1],lo[k][2],lo[k][3],hh[k][0],hh[k][1],hh[k][2],hh[k][3]}
      o[d0]=__builtin_amdgcn_mfma_f32_32x32x16_bf16(PAF(0),PK(0),o[d0],0,0,0);
      o[d0]=__builtin_amdgcn_mfma_f32_32x32x16_bf16(PAF(1),PK(1),o[d0],0,0,0);
      o[d0]=__builtin_amdgcn_mfma_f32_32x32x16_bf16(PAF(2),PK(2),o[d0],0,0,0);
      o[d0]=__builtin_amdgcn_mfma_f32_32x32x16_bf16(PAF(3),PK(3),o[d0],0,0,0);
      #undef PK
    } }
  #undef PKW
  #undef PAF
  #undef VFR
  #undef PIN
  #undef MX3
  #undef GAPB
  #undef EXS
  #undef VRD
  #undef KRD1
  #undef QKG
  #undef STEP
  #undef ENDW
  asm volatile("s_waitcnt lgkmcnt(0)\n\ts_barrier":::"memory");
  if(nx.on)attn_prime(nx.rowbase,nx.K,nx.V,shm);
  {auto rr=__builtin_amdgcn_permlane32_swap(__float_as_uint(l_reg),__float_as_uint(l_reg),false,false);l_reg=__uint_as_float(rr[0])+__uint_as_float(rr[1]);}
  if(hi==0)wsf[32+r32]=l_reg;asm volatile("s_waitcnt lgkmcnt(0)":::"memory");
  #pragma unroll
  for(int r=0;r<16;++r){ const float rl=__builtin_amdgcn_rcpf(wsf[32+crow(r,hi)]);
    #pragma unroll
    for(int d0=0;d0<4;++d0)o[d0][r]*=rl; }
  #undef DMA_K
  #undef DMA_V
  #undef CMASK
  #undef RESC
  #undef ROT
}
__device__ __forceinline__ void diff_attn_unit(long rowbase,int qb,const bf16*Q1,const bf16*K1,const bf16*Q2,const bf16*K2,const bf16*V,bf16*ON,float*blob,float lam,const float*swp,float sws,char*shm,const PrimeNext nx){
  f32x16 o[4];
  attn_pass2<8>(rowbase,qb,Q1,K1,V,shm,o,PrimeNext{rowbase,K2,V,1});
  { int ln_=threadIdx.x; asm volatile("":"+v"(ln_)::"memory"); const int lane=ln_&63; float*bp=blob+lane*4;
    const int wid_=__builtin_amdgcn_readfirstlane(ln_>>6);
    char*pk0=shm+V2_LDS_OST+wid_*4096+lane*16, *pk1=shm+V2_LDS_BYTES+wid_*3072+lane*16;
    #pragma unroll
    for(int d0=0;d0<4;++d0)
      #pragma unroll
      for(int g=0;g<2;++g){ u32x4 w; w.x=cvtpk_s(o[d0][8*g],o[d0][8*g+1]); w.y=cvtpk_s(o[d0][8*g+2],o[d0][8*g+3]); w.z=cvtpk_s(o[d0][8*g+4],o[d0][8*g+5]); w.w=cvtpk_s(o[d0][8*g+6],o[d0][8*g+7]);
        const int p=d0*2+g;
        if(p<4) *(u32x4*)(pk0+p*1024)=w; else if(p<7) *(u32x4*)(pk1+(p-4)*1024)=w; else *(u32x4*)(bp)=w; } }
  attn_pass2<8>(rowbase,qb,Q2,K2,V,shm,o,nx);
  int tid_=threadIdx.x; asm volatile("":"+v"(tid_)::"memory");
  const int tid=tid_,lane=tid&63,r32=lane&31,hi=lane>>5; const int wid=__builtin_amdgcn_readfirstlane(tid>>6);
  asm volatile("":::"memory");
  { const float*bp=blob+lane*4; const char*pk0=shm+V2_LDS_OST+wid*4096+lane*16, *pk1=shm+V2_LDS_BYTES+wid*3072+lane*16;
    #pragma unroll
    for(int d0=0;d0<4;++d0)
      #pragma unroll
      for(int g=0;g<2;++g){ const int p=d0*2+g; u32x4 w; if(p<4) w=*(const u32x4*)(pk0+p*1024); else if(p<7) w=*(const u32x4*)(pk1+(p-4)*1024); else w=*(const u32x4*)(bp);
        const float a0=__uint_as_float(w.x<<16),a1=__uint_as_float(w.x&0xffff0000u),a2=__uint_as_float(w.y<<16),a3=__uint_as_float(w.y&0xffff0000u),a4=__uint_as_float(w.z<<16),a5=__uint_as_float(w.z&0xffff0000u),a6=__uint_as_float(w.w<<16),a7=__uint_as_float(w.w&0xffff0000u);
        o[d0][8*g]=a0-lam*o[d0][8*g]; o[d0][8*g+1]=a1-lam*o[d0][8*g+1]; o[d0][8*g+2]=a2-lam*o[d0][8*g+2]; o[d0][8*g+3]=a3-lam*o[d0][8*g+3];
        o[d0][8*g+4]=a4-lam*o[d0][8*g+4]; o[d0][8*g+5]=a5-lam*o[d0][8*g+5]; o[d0][8*g+6]=a6-lam*o[d0][8*g+6]; o[d0][8*g+7]=a7-lam*o[d0][8*g+7]; } }
  float rs[16];
  #pragma unroll
  for(int r=0;r<16;++r){ float ss=(o[0][r]*o[0][r]+o[1][r]*o[1][r])+(o[2][r]*o[2][r]+o[3][r]*o[3][r]);
    ss+=dppf<0xB1>(ss); ss+=dppf<0x4E>(ss); ss+=dppf<0x141>(ss); ss+=dppf<0x140>(ss);
    { auto rr=__builtin_amdgcn_permlane16_swap(__float_as_uint(ss),__float_as_uint(ss),false,false); ss=__uint_as_float(rr[0])+__uint_as_float(rr[1]); }
    rs[r]=1.f/sqrtf(ss*(1.f/128.f)+1e-5f); }
  const float sw0=swp[r32]*sws,sw1=swp[32+r32]*sws,sw2=swp[64+r32]*sws,sw3=swp[96+r32]*sws;
  bf16*Ow=ON+(rowbase+qb*QB+wid*QBLK)*DM;
  bf16*stg=(bf16*)(shm+V2_LDS_OST)+wid*2048;
  #pragma unroll
  for(int rd=0;rd<2;++rd){
    #pragma unroll
    for(int r=0;r<16;++r){const int orow=crow(r,hi);
      stg[orow*64+r32]=__float2bfloat16(o[2*rd][r]*rs[r]*(rd?sw2:sw0));
      stg[orow*64+32+r32]=__float2bfloat16(o[2*rd+1][r]*rs[r]*(rd?sw3:sw1)); }
    asm volatile("s_waitcnt lgkmcnt(0)":::"memory");
    #pragma unroll
    for(int i=0;i<4;++i){const int row=i*8+(lane>>3),ch=lane&7; const u32x4 v=*(const u32x4*)(stg+row*64+ch*8); *(u32x4*)(Ow+(long)row*DM+rd*64+ch*8)=v;}
    asm volatile("s_waitcnt lgkmcnt(0)":::"memory"); }
  asm volatile("s_waitcnt vmcnt(0) lgkmcnt(0)\n\ts_barrier":::"memory");
}
constexpr int ATTN2_LDS_BYTES=V2_LDS_BYTES;
#undef SBAR
#undef WAIT_BAR
}

constexpr int NWAVES = 8, NTHR = NWAVES * 64;
constexpr int BATCH = 16, SEQ = 2048, DMODEL = 1024, TOK = BATCH * SEQ;
constexpr int GATE0 = 3584, GATEW = 2048;
constexpr int POOLW = 512, INW = 5632, NEXP = 32, TOPK = 4, NLAYER = 2;
constexpr int CAP = TOK;
constexpr int MAXROWS = TOK * TOPK + NEXP * 256;
constexpr float LN_EPS = 1e-5f, ALPHA = 1.41421356237309515f;
constexpr float SW_ALPHA = 1.702f, SW_LIMIT = 7.0f;

constexpr size_t MiB = 1u << 20;
constexpr size_t WS_CTL = 0, CTL_ZERO_BYTES = 64 * 1024;
constexpr size_t WS_CS    = 1 * MiB;
constexpr size_t WS_TOKE  = 3 * MiB;
constexpr size_t WS_TOKG  = WS_TOKE + MiB / 2;
constexpr size_t WS_RTOK  = 4 * MiB;
constexpr size_t WS_WRT   = 8 * MiB;
constexpr size_t WS_WIN   = 9 * MiB;
constexpr size_t WS_WPF   = 1464 * MiB;
constexpr size_t WS_WAB   = 33 * MiB;
constexpr size_t WS_WOUT  = 37 * MiB;
constexpr size_t WS_WGU   = 41 * MiB;
constexpr size_t WS_WD    = 297 * MiB;
constexpr size_t WS_XB    = 425 * MiB;
constexpr size_t WS_PROJ  = 489 * MiB;
constexpr size_t WS_U = WS_PROJ, WS_Q = WS_U + 32 * MiB, WS_K = WS_Q + 64 * MiB, WS_V = WS_K + 64 * MiB, WS_G = WS_V + 64 * MiB;
constexpr size_t WS_ACT   = 1705 * MiB;
constexpr size_t WS_DP    = 1400 * MiB;
constexpr size_t WS_ATT   = 873 * MiB;
constexpr size_t WS_O1 = WS_ATT, WS_O2 = WS_O1 + 64 * MiB, WS_ON = WS_O2 + 64 * MiB, WS_YPG = WS_ON + 64 * MiB;
constexpr size_t WS_YS    = WS_ATT;
constexpr size_t WS_MRG   = 1193 * MiB;
constexpr size_t WS_Y     = 1257 * MiB;
constexpr size_t WS_X1    = 1385 * MiB;
constexpr size_t WS_X1B   = 1513 * MiB;
constexpr size_t WS_X2    = 1577 * MiB;
constexpr size_t WS_XB8   = WS_X2;
constexpr size_t WS_WIN8  = WS_X2 + 64 * MiB;
constexpr size_t WS_END   = 1841 * MiB;
static_assert((size_t)MAXROWS * 1024 * 2 <= 352 * MiB && (size_t)MAXROWS * 1024 * 2 <= 320 * MiB, "overlays");
constexpr int CW_CURSOR = 8192;
constexpr size_t WS_STATS = 1385 * MiB;
constexpr int CW_BAR = 4096;
static_assert((CW_CURSOR + NLAYER * 32 * 64) * 4 <= (int)CTL_ZERO_BYTES && (CW_BAR + 3456) <= CW_CURSOR, "control words inside the per-call memset");

constexpr int RING_OFF = 0, RING_BYTES = 139264;
constexpr int MISC_OFF = 155648;
constexpr int LDS_BYTES = 163840;
constexpr int TAB_CNT = 16, TAB_BLK = 48, TAB_RB = 96;
static_assert(TAB_RB - TAB_BLK == pg8::TAB_RB_REL, "rb table offset");
static_assert(pg8::EPI_LDS_OFF == RING_BYTES && pg8::EPI_LDS_OFF + 2 * 8192 <= MISC_OFF, "epilogue-operand slots between the phase scratch and the control words");
static_assert(attn_body::V2_LDS_BYTES + 8 * 3072 <= MISC_OFF && MISC_OFF + 8192 <= LDS_BYTES && RING_BYTES <= MISC_OFF, "attention O1 park sits between the rings and the control words");

#define GAS __attribute__((address_space(1)))
#define LAS __attribute__((address_space(3)))
typedef unsigned short bf16;
typedef unsigned v4u __attribute__((ext_vector_type(4)));
typedef unsigned v2u __attribute__((ext_vector_type(2)));
typedef float f32x4 __attribute__((ext_vector_type(4)));
typedef float f32x2 __attribute__((ext_vector_type(2)));
typedef GAS unsigned gu32;
#define RLX_AGENT __ATOMIC_RELAXED, __HIP_MEMORY_SCOPE_AGENT
#define LDS_WAIT() asm volatile("s_waitcnt lgkmcnt(0)" ::: "memory")
#define VM_WAIT() asm volatile("s_waitcnt vmcnt(0)" ::: "memory")
__device__ __forceinline__ unsigned f2bf(float f) { unsigned u = __builtin_bit_cast(unsigned, f); return (u + 0x7fffu + ((u >> 16) & 1u)) >> 16; }
__device__ __forceinline__ unsigned pk2(float lo, float hi) { return pg8::cvt_pk_bf16(lo, hi); }
using pg8::bf_lo; using pg8::bf_hi;

#define XB_TMO      128
#define XB_XCNT(j)  (256  + 64 * (j))
#define XB_XSUB(j)  (1280 + 64 * (j))
#define XB_XGEN(j)  (2304 + 64 * (j))
#define XB_TOP      3328
#define XB_TOPGEN   3392
#define XCD_BAR_WORDS 3456
#define XB_SPIN_CAP (1u << 18)

__device__ __forceinline__ unsigned xb_ld(unsigned* p)              { return __hip_atomic_load(p, __ATOMIC_RELAXED, __HIP_MEMORY_SCOPE_AGENT); }
__device__ __forceinline__ unsigned xb_add(unsigned* p, unsigned v) { return __hip_atomic_fetch_add(p, v, __ATOMIC_RELAXED, __HIP_MEMORY_SCOPE_AGENT); }
__device__ __forceinline__ unsigned xb_xcc_id() { return (unsigned)__builtin_amdgcn_s_getreg((3 << 11) | 20) & 0xFu; }
#define XB_SPIN(cond, bar) do { unsigned _sp = 0; while (cond) { __builtin_amdgcn_s_sleep(1); \
    if ((++_sp & 255u) == 0u) { if (xb_ld(&(bar)[XB_TMO])) break; if (_sp > XB_SPIN_CAP) { atomicAdd(&(bar)[XB_TMO], 1u); break; } } } } while (0)

struct XcdBarrier {
    unsigned* bar; unsigned x;
    volatile LAS unsigned* st;
};
__device__ __forceinline__ XcdBarrier xcd_barrier_post(unsigned* bar, volatile LAS unsigned* st) {
    XcdBarrier b; b.bar = bar; b.x = xb_xcc_id(); b.st = st;
    if (threadIdx.x == 0) (void)xb_add(&bar[XB_XCNT(b.x)], 1u);
    return b;
}
__device__ __forceinline__ void xcd_barrier_complete(unsigned* bar, unsigned x, unsigned& nloc, unsigned& nx) {
    const unsigned G = gridDim.x * gridDim.y * gridDim.z;
    unsigned sum, cnt, mine, sp = 0u;
    for (;;) {
        sum = 0u; cnt = 0u; mine = 0u;
#pragma unroll
        for (unsigned j = 0; j < 16; ++j) { const unsigned c = xb_ld(&bar[XB_XCNT(j)]); sum += c; cnt += (c > 0u) ? 1u : 0u; mine = (j == x) ? c : mine; }
        if (sum == G) break;
        __builtin_amdgcn_s_sleep(1);
        if ((++sp & 255u) == 0u) { if (xb_ld(&bar[XB_TMO])) break; if (sp > XB_SPIN_CAP) { atomicAdd(&bar[XB_TMO], 1u); break; } }
    }
    nloc = mine > 0u ? mine : 1u; nx = cnt > 0u ? cnt : 1u;
}
__device__ __forceinline__ void xcd_barrier(const XcdBarrier& b) {
    asm volatile("s_waitcnt vmcnt(0)" ::: "memory");
    __syncthreads();
    if (threadIdx.x == 0) {
        unsigned* bar = b.bar;
        __builtin_amdgcn_s_waitcnt(0);
        unsigned nloc = b.st[0], nx = b.st[1];
        if (nloc == 0u) { xcd_barrier_complete(bar, b.x, nloc, nx); b.st[0] = nloc; b.st[1] = nx; }
        const unsigned old = xb_add(&bar[XB_XSUB(b.x)], 1u);
        const unsigned gen = old / nloc;
        if (old + 1u == (gen + 1u) * nloc) {
            __builtin_amdgcn_fence(__ATOMIC_RELEASE, "agent");
            asm volatile("s_waitcnt vmcnt(0)" ::: "memory");
            const unsigned og = xb_add(&bar[XB_TOP], 1u);
            const unsigned tg = og / nx;
            if (og + 1u == (tg + 1u) * nx) xb_add(&bar[XB_TOPGEN], 1u);
            else XB_SPIN(xb_ld(&bar[XB_TOPGEN]) == tg, bar);
            __builtin_amdgcn_fence(__ATOMIC_ACQUIRE, "agent");
            xb_add(&bar[XB_XGEN(b.x)], 1u);
            asm volatile("s_waitcnt vmcnt(0)" ::: "memory");
        } else {
            XB_SPIN(xb_ld(&bar[XB_XGEN(b.x)]) == gen, bar);
            __builtin_amdgcn_fence(__ATOMIC_ACQUIRE, "agent");
            asm volatile("s_waitcnt vmcnt(0)" ::: "memory");
        }
    }
    __syncthreads();
}

struct Frame {
    LAS unsigned char* lds;
    volatile LAS unsigned* MISC;
    gu32* ctl;
    unsigned char* ws;
    int tid, lane, wave;
    int vcu, G;
};

template <int CTRL> __device__ __forceinline__ float dpp_f(float v) { return __builtin_bit_cast(float, __builtin_amdgcn_update_dpp(0, __builtin_bit_cast(int, v), CTRL, 0xf, 0xf, true)); }
template <int CTRL> __device__ __forceinline__ unsigned dpp_u(unsigned v) { return (unsigned)__builtin_amdgcn_update_dpp(0, (int)v, CTRL, 0xf, 0xf, true); }
__device__ __forceinline__ float swap16_add(float a, float b) { auto r = __builtin_amdgcn_permlane16_swap(__float_as_uint(a), __float_as_uint(b), false, false); return __uint_as_float(r[0]) + __uint_as_float(r[1]); }
__device__ __forceinline__ float swap32_add(float a, float b) { auto r = __builtin_amdgcn_permlane32_swap(__float_as_uint(a), __float_as_uint(b), false, false); return __uint_as_float(r[0]) + __uint_as_float(r[1]); }
__device__ __forceinline__ float wave_sum(float v) {
    v += dpp_f<0xB1>(v); v += dpp_f<0x4E>(v); v += dpp_f<0x141>(v); v += dpp_f<0x140>(v);
    v = swap16_add(v, v); v = swap32_add(v, v);
    return v;
}

constexpr int TAB_UNITS = 1024;
__device__ __forceinline__ pg8::TableOrder unit_table(Frame& F, const pg8::StaticOrder& S) {
    __syncthreads();
    if (F.tid < 32) { pg8::Unit u; const bool ok = S.next(F.tid, u); if (ok) { F.MISC[TAB_UNITS + F.tid * 8] = (unsigned)u.pm; F.MISC[TAB_UNITS + F.tid * 8 + 1] = (unsigned)u.pn; }
        const unsigned long long m = __ballot(ok); if (F.tid == 0) F.MISC[TAB_UNITS - 1] = (unsigned)__popcll(m); }
    __syncthreads();
    return pg8::TableOrder{(const LAS int*)(F.lds + MISC_OFF) + TAB_UNITS, (int)F.MISC[TAB_UNITS - 1]};
}

namespace pg8 {
__device__ __forceinline__ u32x4 widen8(u32x2 wa, u32x2 wb) {
    auto rx = __builtin_amdgcn_permlane16_swap(wa.x, wb.x, false, false); auto ry = __builtin_amdgcn_permlane16_swap(wa.y, wb.y, false, false);
    u32x4 o; o.x = rx[0]; o.y = ry[0]; o.z = rx[1]; o.w = ry[1]; return o;
}
__device__ __forceinline__ void unwiden8(u32x4 o, u32x2& wa, u32x2& wb) {
    auto rx = __builtin_amdgcn_permlane16_swap(o.x, o.z, false, false); auto ry = __builtin_amdgcn_permlane16_swap(o.y, o.w, false, false);
    wa.x = rx[0]; wa.y = ry[0]; wb.x = rx[1]; wb.y = ry[1];
}
__device__ __forceinline__ unsigned pack4_u8(f32x4 v) { const f32x4 t = v * 255.f + 0.5f; unsigned w = 0;
    w = __builtin_amdgcn_cvt_pk_u8_f32(t[0], 0, w); w = __builtin_amdgcn_cvt_pk_u8_f32(t[1], 1, w); w = __builtin_amdgcn_cvt_pk_u8_f32(t[2], 2, w); w = __builtin_amdgcn_cvt_pk_u8_f32(t[3], 3, w); return w; }
__device__ __forceinline__ f32x4 unpack4_u8(unsigned w) { return (f32x4){(float)(w & 0xffu), (float)((w >> 8) & 0xffu), (float)((w >> 16) & 0xffu), (float)(w >> 24)}; }
struct EpiInProj {
    static constexpr bool PERM = true, LDSC = true;
    __device__ __forceinline__ void stage(const Unit& u, PG8_LAS unsigned char* slot, int wid, int lane) const {
        const int pn = u.pn + pn0; if (pn < 2 || pn >= 10) return;
        const unsigned* src = (const unsigned*)cs + ((size_t)u.pm * BM + wid * 32) * 8 + lane * 4;
        __builtin_amdgcn_global_load_lds(src, (PG8_LAS unsigned*)(slot + wid * 1024), 16, 0, 0);
    }
    bf16_t *U, *Q, *Kb, *V, *Gt; const float* cs; int pn0; float ds;
    __device__ __forceinline__ void operator()(const f32x4 (&acc)[2][2][4][2], const Unit& u, int wr, int wc, int fr, int fq, const PG8_LAS unsigned char* eslot) const {
        const int pn = u.pn + pn0; bf16_t* base; int ldc, colt, mode;
        if (pn < 2) { base = U; ldc = 512; colt = pn * 256; mode = 0; }
        else if (pn < 6) { base = Q; ldc = 1024; colt = (pn - 2) * 256; mode = 1; }
        else if (pn < 10) { base = Kb; ldc = 1024; colt = (pn - 6) * 256; mode = 2; }
        else if (pn < 14) { base = V; ldc = 1024; colt = (pn - 10) * 256; mode = 0; }
        else { base = Gt; ldc = 2048; colt = (pn - 14) * 256; mode = 3; }
        const int row0 = u.pm * BM + wr * 64 + fr, col0 = colt + wc * 32 + 8 * fq;
        const bool rot = (mode == 1 || mode == 2) && ((wc & 1) == 0);
        const float sgn = (fq == 0) ? -1.f : 1.f; const bool act = fq < 2;
        const float sc = (mode == 1) ? attn_body::C2 : 1.f;
        u32x2 pend[2] = {{0u, 0u}, {0u, 0u}};
#pragma unroll
        for (int ai = 0; ai < 2; ++ai)
#pragma unroll
            for (int m = 0; m < 4; ++m) { const int row = row0 + ai * HALF + m * 16; bf16_t* rowp = base + (size_t)row * ldc + col0;
                f32x4 c0 = {1.f, 1.f, 1.f, 1.f}, c1 = c0, s0 = {0.f, 0.f, 0.f, 0.f}, s1 = s0;
                if (rot) { const PG8_LAS u32x4* t = (const PG8_LAS u32x4*)(eslot + (wr * 64 + fr + ai * HALF + m * 16) * 32); const u32x4 w0 = t[0], w1 = t[1];
#pragma unroll
                    for (int i = 0; i < 4; ++i) { c0[i] = (float)__builtin_bit_cast(_Float16, (unsigned short)(w0[i] & 0xffffu)); s0[i] = (float)__builtin_bit_cast(_Float16, (unsigned short)(w0[i] >> 16));
                        c1[i] = (float)__builtin_bit_cast(_Float16, (unsigned short)(w1[i] & 0xffffu)); s1[i] = (float)__builtin_bit_cast(_Float16, (unsigned short)(w1[i] >> 16)); } }
#pragma unroll
                for (int bj = 0; bj < 2; ++bj) { f32x4 v0 = acc[ai][bj][m][0], v1 = acc[ai][bj][m][1];
                    if (rot) { f32x4 p0, p1;
#pragma unroll
                        for (int i = 0; i < 4; ++i) { auto r0 = __builtin_amdgcn_permlane16_swap(__float_as_uint(v0[i]), __float_as_uint(v0[i]), false, false); p0[i] = __uint_as_float((fq & 1) ? r0[0] : r0[1]);
                            auto r1 = __builtin_amdgcn_permlane16_swap(__float_as_uint(v1[i]), __float_as_uint(v1[i]), false, false); p1[i] = __uint_as_float((fq & 1) ? r1[0] : r1[1]); }
                        if (act) { v0 = v0 * c0 + (p0 * s0) * sgn; v1 = v1 * c1 + (p1 * s1) * sgn; } }
                    if (mode == 3) { const f32x4 z0 = v0 * (-1.4426950408889634f * ds), z1 = v1 * (-1.4426950408889634f * ds); f32x4 e0, e1;
#pragma unroll
                        for (int i = 0; i < 4; ++i) { e0[i] = __builtin_amdgcn_exp2f(z0[i]); e1[i] = __builtin_amdgcn_exp2f(z1[i]); }
                        e0 = e0 + 1.f; e1 = e1 + 1.f;
#pragma unroll
                        for (int i = 0; i < 4; ++i) { v0[i] = __builtin_amdgcn_rcpf(e0[i]); v1[i] = __builtin_amdgcn_rcpf(e1[i]); }
                        u32x2 q; q.x = pack4_u8(v0); q.y = pack4_u8(v1);
                        if ((m & 1) == 0) pend[bj] = q;
                        else { const u32x4 o = widen8(pend[bj], q); const int odd = fq & 1;
                            *(u32x4*)((unsigned char*)Gt + (size_t)(row - 16 + 16 * odd) * 2048 + col0 + bj * HALF - 8 * odd) = o; }
                        continue; }
                    v0 = v0 * sc; v1 = v1 * sc;
                    u32x4 w; w.x = cvt_pk_bf16(v0[0], v0[1]); w.y = cvt_pk_bf16(v0[2], v0[3]); w.z = cvt_pk_bf16(v1[0], v1[1]); w.w = cvt_pk_bf16(v1[2], v1[3]);
                    *(u32x4*)(rowp + bj * HALF) = w; } }
    }
};
struct EpiGateF {
    static constexpr bool PERM = true, LDSC = false;
    const unsigned char* G8; bf16_t* MRG;
    __device__ __forceinline__ void mid(f32x4 (&acc)[2][2][4][2], const Unit& u, int wr, int wc, int fr, int fq, const PG8_LAS unsigned char* eslot) const {
        const int row0 = u.pm * BM + wr * 64 + fr, col0 = u.pn * BM + wc * 32 + 8 * fq, odd = fq & 1;
#pragma unroll
        for (int ai = 0; ai < 2; ++ai) { u32x4 g0q[2][2], g1q[2][2];
#pragma unroll
            for (int mp = 0; mp < 2; ++mp)
#pragma unroll
                for (int bj = 0; bj < 2; ++bj) { const unsigned char* p = G8 + (size_t)(row0 + ai * HALF + (2 * mp + odd) * 16) * 2048 + col0 + bj * HALF - 8 * odd;
                    g0q[mp][bj] = *(const u32x4*)p; g1q[mp][bj] = *(const u32x4*)(p + 1024); }
#pragma unroll
            for (int mp = 0; mp < 2; ++mp)
#pragma unroll
                for (int bj = 0; bj < 2; ++bj) { u32x2 a0, b0, a1, b1; unwiden8(g0q[mp][bj], a0, b0); unwiden8(g1q[mp][bj], a1, b1);
#pragma unroll
                    for (int q = 0; q < 2; ++q) { const int m = 2 * mp + q; const u32x2 n0 = q ? b0 : a0, n1 = q ? b1 : a1;
#pragma unroll
                        for (int h = 0; h < 2; ++h) { const f32x4 num = unpack4_u8(h ? n0.y : n0.x); f32x4 den = unpack4_u8(h ? n1.y : n1.x); f32x4 r;
#pragma unroll
                            for (int i = 0; i < 4; ++i) r[i] = num[i] * __builtin_amdgcn_rcpf(fmaxf(den[i], 1.f));
                            acc[ai][bj][m][h] = acc[ai][bj][m][h] * r; } } }
            asm volatile("" ::: "memory"); }
    }
    __device__ __forceinline__ void operator()(const f32x4 (&acc)[2][2][4][2], const Unit& u, int wr, int wc, int fr, int fq, const PG8_LAS unsigned char* eslot) const {
        const int row0 = u.pm * BM + wr * 64 + fr, col0 = u.pn * BM + wc * 32 + 8 * fq, odd = fq & 1;
#pragma unroll
        for (int ai = 0; ai < 2; ++ai) { u32x4 gq[2][2];
#pragma unroll
            for (int mp = 0; mp < 2; ++mp)
#pragma unroll
                for (int bj = 0; bj < 2; ++bj) gq[mp][bj] = *(const u32x4*)(G8 + (size_t)(row0 + ai * HALF + (2 * mp + odd) * 16) * 2048 + 1024 + col0 + bj * HALF - 8 * odd);
#pragma unroll
            for (int mp = 0; mp < 2; ++mp)
#pragma unroll
                for (int bj = 0; bj < 2; ++bj) { u32x2 ga, gb; unwiden8(gq[mp][bj], ga, gb); const int col = col0 + bj * HALF;
#pragma unroll
                    for (int q = 0; q < 2; ++q) { const int m = 2 * mp + q; const int row = row0 + ai * HALF + m * 16; const u32x2 g = q ? gb : ga;
                        f32x4 d0 = unpack4_u8(g.x), d1 = unpack4_u8(g.y);
#pragma unroll
                        for (int i = 0; i < 4; ++i) { d0[i] = fmaxf(d0[i], 1.f); d1[i] = fmaxf(d1[i], 1.f); }
                        const f32x4 v0 = acc[ai][bj][m][0] * (1.f / 255.f) * d0, v1 = acc[ai][bj][m][1] * (1.f / 255.f) * d1;
                        u32x4 w; w.x = cvt_pk_bf16(v0[0], v0[1]); w.y = cvt_pk_bf16(v0[2], v0[3]); w.z = cvt_pk_bf16(v1[0], v1[1]); w.w = cvt_pk_bf16(v1[2], v1[3]);
                        *(u32x4*)(MRG + (size_t)row * 1024 + col) = w; } }
            asm volatile("" ::: "memory"); }
    }
};
struct EpiGate0 {
    static constexpr bool PERM = true, LDSC = false;
    bf16_t* MRG; const unsigned char* G8;
    __device__ __forceinline__ void operator()(const f32x4 (&acc)[2][2][4][2], const Unit& u, int wr, int wc, int fr, int fq, const PG8_LAS unsigned char* eslot) const {
        const int row0 = u.pm * BM + wr * 64 + fr, col0 = u.pn * BM + wc * 32 + 8 * fq, odd = fq & 1;
#pragma unroll
        for (int ai = 0; ai < 2; ++ai) { u32x4 gq[2][2];
#pragma unroll
            for (int mp = 0; mp < 2; ++mp)
#pragma unroll
                for (int bj = 0; bj < 2; ++bj) gq[mp][bj] = *(const u32x4*)(G8 + (size_t)(row0 + ai * HALF + (2 * mp + odd) * 16) * 2048 + col0 + bj * HALF - 8 * odd);
#pragma unroll
            for (int mp = 0; mp < 2; ++mp)
#pragma unroll
                for (int bj = 0; bj < 2; ++bj) { u32x2 ga, gb; unwiden8(gq[mp][bj], ga, gb); const int col = col0 + bj * HALF;
#pragma unroll
                    for (int q = 0; q < 2; ++q) { const int m = 2 * mp + q; const int row = row0 + ai * HALF + m * 16; const u32x2 g = q ? gb : ga;
                        const f32x4 v0 = acc[ai][bj][m][0] * (1.f / 255.f) * unpack4_u8(g.x), v1 = acc[ai][bj][m][1] * (1.f / 255.f) * unpack4_u8(g.y);
                        u32x4 w; w.x = cvt_pk_bf16(v0[0], v0[1]); w.y = cvt_pk_bf16(v0[2], v0[3]); w.z = cvt_pk_bf16(v1[0], v1[1]); w.w = cvt_pk_bf16(v1[2], v1[3]);
                        *(u32x4*)(MRG + (size_t)row * 1024 + col) = w; } }
            asm volatile("" ::: "memory"); }
    }
};
struct EpiGate1 {
    static constexpr bool PERM = true, LDSC = false;
    const unsigned char* G8; bf16_t* MRG;
    __device__ __forceinline__ void operator()(const f32x4 (&acc)[2][2][4][2], const Unit& u, int wr, int wc, int fr, int fq, const PG8_LAS unsigned char* eslot) const {
        const int row0 = u.pm * BM + wr * 64 + fr, col0 = u.pn * BM + wc * 32 + 8 * fq, odd = fq & 1;
#pragma unroll
        for (int ai = 0; ai < 2; ++ai) { u32x4 gq[2][2], yw[4][2];
#pragma unroll
            for (int mp = 0; mp < 2; ++mp)
#pragma unroll
                for (int bj = 0; bj < 2; ++bj) gq[mp][bj] = *(const u32x4*)(G8 + (size_t)(row0 + ai * HALF + (2 * mp + odd) * 16) * 2048 + 1024 + col0 + bj * HALF - 8 * odd);
#pragma unroll
            for (int m = 0; m < 4; ++m)
#pragma unroll
                for (int bj = 0; bj < 2; ++bj) yw[m][bj] = *(const u32x4*)(MRG + (size_t)(row0 + ai * HALF + m * 16) * 1024 + col0 + bj * HALF);
#pragma unroll
            for (int mp = 0; mp < 2; ++mp)
#pragma unroll
                for (int bj = 0; bj < 2; ++bj) { u32x2 ga, gb; unwiden8(gq[mp][bj], ga, gb); const int col = col0 + bj * HALF;
#pragma unroll
                    for (int q = 0; q < 2; ++q) { const int m = 2 * mp + q; const int row = row0 + ai * HALF + m * 16; const u32x2 g = q ? gb : ga; const u32x4 y = yw[m][bj];
                        f32x4 v0 = acc[ai][bj][m][0] * (1.f / 255.f) * unpack4_u8(g.x), v1 = acc[ai][bj][m][1] * (1.f / 255.f) * unpack4_u8(g.y);
                        v0[0] += bf_lo(y.x); v0[1] += bf_hi(y.x); v0[2] += bf_lo(y.y); v0[3] += bf_hi(y.y); v1[0] += bf_lo(y.z); v1[1] += bf_hi(y.z); v1[2] += bf_lo(y.w); v1[3] += bf_hi(y.w);
                        u32x4 w; w.x = cvt_pk_bf16(v0[0], v0[1]); w.y = cvt_pk_bf16(v0[2], v0[3]); w.z = cvt_pk_bf16(v1[0], v1[1]); w.w = cvt_pk_bf16(v1[2], v1[3]);
                        *(u32x4*)(MRG + (size_t)row * 1024 + col) = w; } }
            asm volatile("" ::: "memory"); }
    }
};
struct EpiOut {
    static constexpr bool PERM = true, LDSC = false;
    const float* Xf; const bf16_t* Xb; bf16_t* Y; float* ST;
    __device__ __forceinline__ void operator()(const f32x4 (&acc)[2][2][4][2], const Unit& u, int wr, int wc, int fr, int fq, const PG8_LAS unsigned char* eslot) const {
        const int row0 = u.pm * BM + wr * 64 + fr, col0 = u.pn * BM + wc * 32 + 8 * fq;
#pragma unroll
        for (int ai = 0; ai < 2; ++ai) { f32x4 xs[4][2][2];
            if (Xf) {
#pragma unroll
                for (int m = 0; m < 4; ++m)
#pragma unroll
                    for (int bj = 0; bj < 2; ++bj) { const float* p = Xf + (size_t)(row0 + ai * HALF + m * 16) * 1024 + col0 + bj * HALF; xs[m][bj][0] = *(const f32x4*)p; xs[m][bj][1] = *(const f32x4*)(p + 4); }
            } else { u32x4 xw[4][2];
#pragma unroll
                for (int m = 0; m < 4; ++m)
#pragma unroll
                    for (int bj = 0; bj < 2; ++bj) xw[m][bj] = *(const u32x4*)(Xb + (size_t)(row0 + ai * HALF + m * 16) * 1024 + col0 + bj * HALF);
#pragma unroll
                for (int m = 0; m < 4; ++m)
#pragma unroll
                    for (int bj = 0; bj < 2; ++bj) { const u32x4 w = xw[m][bj]; xs[m][bj][0] = (f32x4){bf_lo(w.x), bf_hi(w.x), bf_lo(w.y), bf_hi(w.y)}; xs[m][bj][1] = (f32x4){bf_lo(w.z), bf_hi(w.z), bf_lo(w.w), bf_hi(w.w)}; } }
#pragma unroll
            for (int m = 0; m < 4; ++m) { const int row = row0 + ai * HALF + m * 16; const size_t off = (size_t)row * 1024 + col0; float s1 = 0.f, s2 = 0.f;
#pragma unroll
                for (int bj = 0; bj < 2; ++bj) {
                    const f32x4 y0 = xs[m][bj][0] * ALPHA + acc[ai][bj][m][0], y1 = xs[m][bj][1] * ALPHA + acc[ai][bj][m][1];
                    u32x4 w; w.x = cvt_pk_bf16(y0[0], y0[1]); w.y = cvt_pk_bf16(y0[2], y0[3]); w.z = cvt_pk_bf16(y1[0], y1[1]); w.w = cvt_pk_bf16(y1[2], y1[3]);
                    *(u32x4*)(Y + off + bj * HALF) = w;
                    s1 += ((y0[0] + y0[1]) + (y0[2] + y0[3])) + ((y1[0] + y1[1]) + (y1[2] + y1[3]));
                    s2 += ((y0[0] * y0[0] + y0[1] * y0[1]) + (y0[2] * y0[2] + y0[3] * y0[3])) + ((y1[0] * y1[0] + y1[1] * y1[1]) + (y1[2] * y1[2] + y1[3] * y1[3])); }
                { auto r = __builtin_amdgcn_permlane16_swap(__float_as_uint(s1), __float_as_uint(s1), false, false); s1 = __uint_as_float(r[0]) + __uint_as_float(r[1]); }
                { auto r = __builtin_amdgcn_permlane32_swap(__float_as_uint(s1), __float_as_uint(s1), false, false); s1 = __uint_as_float(r[0]) + __uint_as_float(r[1]); }
                { auto r = __builtin_amdgcn_permlane16_swap(__float_as_uint(s2), __float_as_uint(s2), false, false); s2 = __uint_as_float(r[0]) + __uint_as_float(r[1]); }
                { auto r = __builtin_amdgcn_permlane32_swap(__float_as_uint(s2), __float_as_uint(s2), false, false); s2 = __uint_as_float(r[0]) + __uint_as_float(r[1]); }
                if (fq == 0) { typedef float f32x2v __attribute__((ext_vector_type(2))); *(f32x2v*)(ST + ((size_t)row * 16 + (u.pn & 3) * 4 + wc) * 2) = (f32x2v){s1, s2}; } }
            asm volatile("" ::: "memory"); }
    }
};
struct EpiSwiglu {
    static constexpr bool PERM = true, LDSC = true;
    __device__ __forceinline__ void stage(const Unit& u, PG8_LAS unsigned char* slot, int wid, int lane) const {
        if (wid != 0) return;
        const float* src = bgu + (size_t)u.e * 2048 + (u.pn & 7) * 128 + ((lane & 32) ? 1024 : 0) + (lane & 31) * 4;
        __builtin_amdgcn_global_load_lds((const unsigned*)src, (PG8_LAS unsigned*)slot, 16, 0, 0);
    }
    unsigned char* ACT; const float* bgu;
    typedef float f2 __attribute__((ext_vector_type(2)));
    static __device__ __forceinline__ f2 act2(f2 ag, f2 au, f2 bg, f2 bu) {
        const f2 g = ag * (1.f / 256.f) + bg, u = au * (1.f / 256.f) + bu;
        f2 hg, hu; hg.x = fminf(g.x, SW_LIMIT); hg.y = fminf(g.y, SW_LIMIT); hu.x = __builtin_amdgcn_fmed3f(u.x, -SW_LIMIT, SW_LIMIT); hu.y = __builtin_amdgcn_fmed3f(u.y, -SW_LIMIT, SW_LIMIT);
        const f2 z = hg * (-SW_ALPHA * 1.4426950408889634f);
        f2 e; e.x = __builtin_amdgcn_exp2f(z.x); e.y = __builtin_amdgcn_exp2f(z.y);
        const f2 d = e + 1.f;
        f2 r; r.x = __builtin_amdgcn_rcpf(d.x); r.y = __builtin_amdgcn_rcpf(d.y);
        const f2 t = hu * 4.f + 4.f;
        return (t * hg) * r;
    }
    __device__ __forceinline__ void operator()(const f32x4 (&acc)[2][2][4][2], const Unit& u, int wr, int wc, int fr, int fq, const PG8_LAS unsigned char* eslot) const {
        const int pnl = u.pn & 7, j0 = pnl * 128 + wc * 32 + 8 * fq;
        const PG8_LAS float* bg = (const PG8_LAS float*)eslot + wc * 32 + 8 * fq;
        const f32x4 bg0 = *(const PG8_LAS f32x4*)bg, bg1 = *(const PG8_LAS f32x4*)(bg + 4), bu0 = *(const PG8_LAS f32x4*)(bg + 128), bu1 = *(const PG8_LAS f32x4*)(bg + 132);
        const int row0 = u.pm * BM + wr * 64 + fr;
        const int odd = fq & 1;
#pragma unroll
        for (int ai = 0; ai < 2; ++ai)
#pragma unroll
            for (int mp = 0; mp < 2; ++mp) { u32x2 w[2];
#pragma unroll
                for (int q = 0; q < 2; ++q) { const int m = 2 * mp + q;
                    const f32x4 g0 = acc[ai][0][m][0], g1 = acc[ai][0][m][1], u0 = acc[ai][1][m][0], u1 = acc[ai][1][m][1];
                    const f2 a00 = act2((f2){g0[0], g0[1]}, (f2){u0[0], u0[1]}, (f2){bg0[0], bg0[1]}, (f2){bu0[0], bu0[1]});
                    const f2 a01 = act2((f2){g0[2], g0[3]}, (f2){u0[2], u0[3]}, (f2){bg0[2], bg0[3]}, (f2){bu0[2], bu0[3]});
                    const f2 a10 = act2((f2){g1[0], g1[1]}, (f2){u1[0], u1[1]}, (f2){bg1[0], bg1[1]}, (f2){bu1[0], bu1[1]});
                    const f2 a11 = act2((f2){g1[2], g1[3]}, (f2){u1[2], u1[3]}, (f2){bg1[2], bg1[3]}, (f2){bu1[2], bu1[3]});
                    w[q].x = cvt4_fp8(a00.x, a00.y, a01.x, a01.y); w[q].y = cvt4_fp8(a10.x, a10.y, a11.x, a11.y); }
                const u32x4 o = widen8(w[0], w[1]);
                const int row = row0 + ai * HALF + (2 * mp + odd) * 16;
                *(u32x4*)(ACT + (size_t)row * 1024 + j0 - 8 * odd) = o; }
    }
};
struct EpiDown {
    static constexpr bool PERM = true, LDSC = true;
    __device__ __forceinline__ void stage(const Unit& u, PG8_LAS unsigned char* slot, int wid, int lane) const {
        if (wid != 0) return;
        const float* src = bd + (size_t)u.e * 1024 + (u.pn & 3) * 256 + lane * 4;
        __builtin_amdgcn_global_load_lds((const unsigned*)src, (PG8_LAS unsigned*)slot, 16, 0, 0);
    }
    unsigned char* YS; const float* bd;
    __device__ __forceinline__ void operator()(const f32x4 (&acc)[2][2][4][2], const Unit& u, int wr, int wc, int fr, int fq, const PG8_LAS unsigned char* eslot) const {
        const int pnl = u.pn & 3, col0 = pnl * 256 + wc * 32 + 8 * fq;
        const PG8_LAS float* bp = (const PG8_LAS float*)eslot + wc * 32 + 8 * fq;
        f32x4 bv[2][2];
#pragma unroll
        for (int bj = 0; bj < 2; ++bj) { bv[bj][0] = *(const PG8_LAS f32x4*)(bp + bj * HALF) * 64.f; bv[bj][1] = *(const PG8_LAS f32x4*)(bp + bj * HALF + 4) * 64.f; }
        const int row0 = u.pm * BM + wr * 64 + fr;
        const int odd = fq & 1;
#pragma unroll
        for (int ai = 0; ai < 2; ++ai)
#pragma unroll
            for (int mp = 0; mp < 2; ++mp)
#pragma unroll
                for (int bj = 0; bj < 2; ++bj) { u32x2 w[2];
#pragma unroll
                    for (int q = 0; q < 2; ++q) { const int m = 2 * mp + q; const f32x4 v0 = acc[ai][bj][m][0] * 0.25f + bv[bj][0], v1 = acc[ai][bj][m][1] * 0.25f + bv[bj][1];
                        w[q].x = cvt4_fp8(v0[0], v0[1], v0[2], v0[3]); w[q].y = cvt4_fp8(v1[0], v1[1], v1[2], v1[3]); }
                    const u32x4 o = widen8(w[0], w[1]);
                    const int row = row0 + ai * HALF + (2 * mp + odd) * 16;
                    *(u32x4*)(YS + (size_t)row * 1024 + col0 + bj * HALF - 8 * odd) = o; }
    }
};
}

__device__ __forceinline__ void transpose64(const float* W, int N, bf16* WT, int Kd, int k0, int n0, int drow0, LAS float* scr, int lane) {
    const int c4 = (lane & 15) * 4, kr = lane >> 4;
    f32x4 v[16];
#pragma unroll
    for (int i = 0; i < 16; ++i) v[i] = *(const GAS f32x4*)(W + (size_t)(k0 + 4 * i + kr) * N + n0 + c4);
#pragma unroll
    for (int i = 0; i < 16; ++i) { LAS float* s = scr + (4 * i + kr) * 65 + c4; s[0] = v[i].x; s[1] = v[i].y; s[2] = v[i].z; s[3] = v[i].w; }
    LDS_WAIT(); asm volatile("" ::: "memory");
    const int c = lane & 7;
#pragma unroll
    for (int j = 0; j < 8; ++j) { const int n = (lane >> 3) + 8 * j; const LAS float* s = scr + (8 * c) * 65 + n;
        v4u o; o.x = pk2(s[0 * 65], s[1 * 65]); o.y = pk2(s[2 * 65], s[3 * 65]); o.z = pk2(s[4 * 65], s[5 * 65]); o.w = pk2(s[6 * 65], s[7 * 65]);
        *(GAS v4u*)(WT + (size_t)(drow0 + n) * Kd + k0 + 8 * c) = o; }
    LDS_WAIT(); asm volatile("" ::: "memory");
}

__device__ __forceinline__ void transpose_fp8_128x128(const float* W, int N, unsigned char* WT, int Kd, int k0, int n0, int drow0, float scale, LAS unsigned* scr, int lane) {
    const int c = lane & 31, kr = lane >> 5;
    f32x4 va[4][4], vb[4][4];
#define T8_LOAD(dst, bt_) do { _Pragma("unroll") for (int g = 0; g < 4; ++g) _Pragma("unroll") for (int j = 0; j < 4; ++j) dst[g][j] = *(const GAS f32x4*)(W + (size_t)(k0 + 32 * (bt_) + 8 * g + 4 * kr + j) * N + n0 + 4 * c); } while (0)
#define T8_PUT(src, bt_) do { _Pragma("unroll") for (int g = 0; g < 4; ++g) _Pragma("unroll") for (int i = 0; i < 4; ++i) \
        scr[(4 * c + i) * 33 + 8 * (bt_) + 2 * g + kr] = pg8::cvt4_fp8(src[g][0][i] * scale, src[g][1][i] * scale, src[g][2][i] * scale, src[g][3][i] * scale); } while (0)
    T8_LOAD(va, 0); T8_LOAD(vb, 1);
    T8_PUT(va, 0); asm volatile("" ::: "memory"); T8_LOAD(va, 2);
    T8_PUT(vb, 1); asm volatile("" ::: "memory"); T8_LOAD(vb, 3);
    T8_PUT(va, 2); T8_PUT(vb, 3);
#undef T8_LOAD
#undef T8_PUT
    LDS_WAIT(); asm volatile("" ::: "memory");
    const int kc = lane & 7;
#pragma unroll 4
    for (int j = 0; j < 16; ++j) { const int n = (lane >> 3) + 8 * j; const LAS unsigned* p = scr + n * 33 + 4 * kc;
        v4u o; o.x = p[0]; o.y = p[1]; o.z = p[2]; o.w = p[3];
        *(GAS v4u*)(WT + (size_t)(drow0 + n) * Kd + k0 + 16 * kc) = o; }
    LDS_WAIT(); asm volatile("" ::: "memory");
}

struct Args { const void* in[23]; float* out; unsigned char* ws; int ph_lo, ph_hi; };
typedef const __attribute__((address_space(4))) Args* ArgsP;

__device__ __forceinline__ ArgsP phase_root(Frame& F) {
    int t_ = threadIdx.x; asm volatile("" : "+v"(t_) :: "memory");
    F.tid = t_; F.lane = t_ & 63; F.wave = __builtin_amdgcn_readfirstlane(t_ >> 6);
    ArgsP ka = (ArgsP)__builtin_amdgcn_kernarg_segment_ptr(); asm volatile("" : "+s"(ka) :: "memory");
    F.ws = ka->ws; F.ctl = (gu32*)(F.ws + WS_CTL);
    return ka;
}

__device__ __forceinline__ void p0_prologue(Frame& F, ArgsP A) {
    LAS float* scr = (LAS float*)(F.lds + RING_OFF + F.wave * 16896);
    const int gw = F.vcu * NWAVES + F.wave, NGW = F.G * NWAVES;
    const float* w_in = (const float*)A->in[2]; const float* w_ab = (const float*)A->in[6]; const float* w_out = (const float*)A->in[12];
    const float* w_gu = (const float*)A->in[17]; const float* w_dn = (const float*)A->in[19];
    bf16* Win = (bf16*)(F.ws + WS_WIN); bf16* Wab = (bf16*)(F.ws + WS_WAB); bf16* Wout = (bf16*)(F.ws + WS_WOUT); unsigned char* Wgu = F.ws + WS_WGU; unsigned char* Wd = F.ws + WS_WD;
    constexpr int I_IN = NLAYER * 16 * (GATE0 / 64), I_IN8 = NLAYER * 8 * (GATEW / 128), I_AB = NLAYER * 256, I_OUT = NLAYER * 256, I_GU = NLAYER * NEXP * 128, I_D = NLAYER * NEXP * 64;
    constexpr int NITEMS = I_IN + I_IN8 + I_AB + I_OUT + I_GU + I_D;
    LAS unsigned* scr8 = (LAS unsigned*)(F.lds + RING_OFF + F.wave * 16896);
    for (int it = gw; it < NITEMS; it += NGW) {
        int r = it;
        if (r < I_GU) { const int mat = r >> 7, q = r & 127, kb = q >> 4, nb = q & 15; const int n0 = nb * 128; const int j0 = n0 & 1023;
            const int drow0 = 256 * (j0 >> 7) + ((n0 >= 1024) ? 128 : 0);
            transpose_fp8_128x128(w_gu + (size_t)mat * 1024 * 2048, 2048, Wgu + (size_t)mat * 2048 * 1024, 1024, kb * 128, n0, drow0, 64.f, scr8, F.lane); continue; } r -= I_GU;
        if (r < I_D) { const int mat = r >> 6, q = r & 63, kb = q >> 3, nb = q & 7;
            transpose_fp8_128x128(w_dn + (size_t)mat * 1024 * 1024, 1024, Wd + (size_t)mat * 1024 * 1024, 1024, kb * 128, nb * 128, nb * 128, 64.f, scr8, F.lane); continue; } r -= I_D;
        if (r < I_IN8) { const int mat = r >> 7, q = r & 127, kb = q >> 4, nb = q & 15;
            transpose_fp8_128x128(w_in + (size_t)mat * 1024 * INW, INW, F.ws + WS_WIN8 + (size_t)mat * GATEW * 1024, 1024, kb * 128, GATE0 + nb * 128, nb * 128, 64.f, scr8, F.lane); continue; } r -= I_IN8;
        if (r < I_IN) { const int mat = r / (16 * 56), q = r % (16 * 56), kb = q / 56, nb = q % 56;
            transpose64(w_in + (size_t)mat * 1024 * INW, INW, Win + (size_t)mat * INW * 1024, 1024, kb * 64, nb * 64, nb * 64, scr, F.lane); continue; } r -= I_IN;
        if (r < I_AB) { const int mat = r >> 8, q = r & 255, kb = q >> 4, nb = q & 15;
            transpose64(w_ab + (size_t)mat * 1024 * 1024, 1024, Wab + (size_t)mat * 1024 * 1024, 1024, kb * 64, nb * 64, nb * 64, scr, F.lane); continue; } r -= I_AB;
        { const int mat = r >> 8, q = r & 255, kb = q >> 4, nb = q & 15;
            transpose64(w_out + (size_t)mat * 1024 * 1024, 1024, Wout + (size_t)mat * 1024 * 1024, 1024, kb * 64, nb * 64, nb * 64, scr, F.lane); }
    }
    const int gt = F.vcu * NTHR + F.tid, NGT = F.G * NTHR;
    { const float* x = (const float*)A->in[0]; bf16* XB = (bf16*)(F.ws + WS_XB);
#pragma unroll 4
      for (int i = gt; i < TOK * DMODEL / 8; i += NGT) { const f32x4 a = *(const GAS f32x4*)(x + (size_t)i * 8), b = *(const GAS f32x4*)(x + (size_t)i * 8 + 4);
          v4u o; o.x = pk2(a.x, a.y); o.y = pk2(a.z, a.w); o.z = pk2(b.x, b.y); o.w = pk2(b.z, b.w); *(GAS v4u*)(XB + (size_t)i * 8) = o;
          v2u q; q.x = pg8::cvt4_fp8(4.f * a.x, 4.f * a.y, 4.f * a.z, 4.f * a.w); q.y = pg8::cvt4_fp8(4.f * b.x, 4.f * b.y, 4.f * b.z, 4.f * b.w); *(GAS v2u*)(F.ws + WS_XB8 + (size_t)i * 8) = q; } }
    { const int* pos = (const int*)A->in[1]; float* cs = (float*)(F.ws + WS_CS);
      for (int i = gt; i < TOK * 8; i += NGT) { const int t = i >> 3, f = i & 7;
          const float invf = exp2f(-(float)f * 2.3664460711655218f);
          const float ang = (float)pos[t] * invf;
          double rev = (double)ang * 0.15915494309189535; rev -= rint(rev); const float fr = (float)rev;
          const _Float16 hc = (_Float16)__builtin_amdgcn_cosf(fr), hs = (_Float16)__builtin_amdgcn_sinf(fr);
          ((unsigned*)cs)[(size_t)t * 8 + f] = (unsigned)__builtin_bit_cast(unsigned short, hc) | ((unsigned)__builtin_bit_cast(unsigned short, hs) << 16); } }
    { const float* wr = (const float*)A->in[15]; bf16* wrh = (bf16*)(F.ws + WS_WRT); bf16* wrl = wrh + NLAYER * 32 * 1024;
      for (int i = gt; i < NLAYER * 32 * 1024; i += NGT) { const int l = i >> 15, e = (i >> 10) & 31, c = i & 1023; const float w = wr[(size_t)l * 32768 + c * 32 + e];
          const unsigned h = f2bf(w); wrh[i] = (bf16)h; wrl[i] = (bf16)f2bf(w - __uint_as_float(h << 16)); } }
    { const float* pw = (const float*)A->in[3]; const float* ps = (const float*)A->in[4]; const float* wpb = (const float*)A->in[5]; bf16* WPF = (bf16*)(F.ws + WS_WPF);
      for (int i = gt; i < NLAYER * 64 * 1024; i += NGT) { const int n = i & 1023; const int kgl = __builtin_amdgcn_readfirstlane(i >> 10), kg = kgl & 63, l = kgl >> 6, g = kg >> 4, c0 = (kg & 15) * 8;
          const float* pr = pw + ((size_t)(l * 4 + g) * 128 + c0) * 128; const float* sr = ps + l * 512 + g * 128; const float* br = wpb + ((size_t)l * 512 + g * 128) * 1024 + n;
          float acc[8] = {0.f, 0.f, 0.f, 0.f, 0.f, 0.f, 0.f, 0.f};
#pragma unroll 8
          for (int d = 0; d < 128; ++d) { const float bv = br[(size_t)d * 1024] * sr[d];
#pragma unroll
              for (int j = 0; j < 8; ++j) acc[j] = fmaf(pr[j * 128 + d], bv, acc[j]); }
          v4u o; o.x = pk2(acc[0], acc[1]); o.y = pk2(acc[2], acc[3]); o.z = pk2(acc[4], acc[5]); o.w = pk2(acc[6], acc[7]);
          *(GAS v4u*)(WPF + ((size_t)l * 1024 + n) * 1024 + g * 128 + c0) = o; } }
}

template <int W> __device__ __forceinline__ void pool_load(const bf16* U, int t, int col, v4u (&v)[W]) {
    const int s = t & (SEQ - 1);
    const bf16* p = U + (size_t)t * POOLW + col;
#pragma unroll
    for (int k = 0; k < W; ++k) v[k] = *(const GAS v4u*)(p - (size_t)((k <= s) ? k : 0) * POOLW);
}
template <int W> __device__ __forceinline__ void pool_fin(bf16* Dp, int t, int col, const v4u (&v)[W]) {
    const int s = t & (SEQ - 1), n = (s + 1 < W) ? s + 1 : W;
    float a[8] = {bf_lo(v[0].x), bf_hi(v[0].x), bf_lo(v[0].y), bf_hi(v[0].y), bf_lo(v[0].z), bf_hi(v[0].z), bf_lo(v[0].w), bf_hi(v[0].w)};
    float sm[8];
#pragma unroll
    for (int j = 0; j < 8; ++j) sm[j] = a[j];
#pragma unroll
    for (int k = 1; k < W; ++k) { const float m = (k <= s) ? 1.f : 0.f;
        sm[0] += m * bf_lo(v[k].x); sm[1] += m * bf_hi(v[k].x); sm[2] += m * bf_lo(v[k].y); sm[3] += m * bf_hi(v[k].y); sm[4] += m * bf_lo(v[k].z); sm[5] += m * bf_hi(v[k].z); sm[6] += m * bf_lo(v[k].w); sm[7] += m * bf_hi(v[k].w); }
    const float inv = 1.f / (float)n;
    v4u o; o.x = pk2(sm[0] * inv - a[0], sm[1] * inv - a[1]); o.y = pk2(sm[2] * inv - a[2], sm[3] * inv - a[3]); o.z = pk2(sm[4] * inv - a[4], sm[5] * inv - a[5]); o.w = pk2(sm[6] * inv - a[6], sm[7] * inv - a[7]);
    *(GAS v4u*)(Dp + (size_t)t * 1024 + col) = o;
}
template <int W> __device__ __forceinline__ void pool_pair(const bf16* U, bf16* Dp, int t0, int c0, int t1, int c1, bool two) {
    v4u va[W], vb[W];
    pool_load<W>(U, t0, c0, va); pool_load<W>(U, two ? t1 : t0, two ? c1 : c0, vb);
    pool_fin<W>(Dp, t0, c0, va); if (two) pool_fin<W>(Dp, t1, c1, vb);
}
__device__ __forceinline__ void pool_phase(Frame& F) {
    const bf16* U = (const bf16*)(F.ws + WS_U); bf16* Dp = (bf16*)(F.ws + WS_DP);
    const int gt = F.vcu * NTHR + F.tid, NGT = F.G * NTHR;
    for (int i = gt; i < TOK * 64; i += 2 * NGT) { const int g = __builtin_amdgcn_readfirstlane(i / (TOK * 16)), r = i - g * (TOK * 16), t = r >> 4, col = g * 128 + (r & 15) * 8;
        const int i1 = i + NGT; const bool two = __builtin_amdgcn_readfirstlane((i1 < TOK * 64) && (i1 / (TOK * 16) == g)) != 0; const int r1 = i1 - g * (TOK * 16), t1 = r1 >> 4, col1 = g * 128 + (r1 & 15) * 8;
        if (g == 0) pool_pair<2>(U, Dp, t, col, t1, col1, two); else if (g == 1) pool_pair<4>(U, Dp, t, col, t1, col1, two); else if (g == 2) pool_pair<8>(U, Dp, t, col, t1, col1, two); else pool_pair<16>(U, Dp, t, col, t1, col1, two);
        if (!two && i1 < TOK * 64) i -= NGT; }
}

constexpr int WR_ROWB = 2064;
constexpr int WR_LO_OFF = 32 * WR_ROWB;
constexpr int RT_SC_OFF = 2 * WR_LO_OFF;
static_assert(RT_SC_OFF + 2 * 8 * 32 * 4 <= RING_BYTES && RING_BYTES + 8192 <= MISC_OFF, "router LDS");
__device__ __forceinline__ void router_phase(Frame& F, ArgsP A, int l) {
    typedef short bf16x8 __attribute__((ext_vector_type(8)));
    const bf16* Y = (const bf16*)(F.ws + WS_Y); const float* ST = (const float*)(F.ws + WS_STATS) + (size_t)l * TOK * 32; unsigned char* X1Q = F.ws + WS_X1B;
    int* TOKE = (int*)(F.ws + WS_TOKE); float* TOKG = (float*)(F.ws + WS_TOKG); int* RTOK = (int*)(F.ws + WS_RTOK);
    const bf16* wrh = (const bf16*)(F.ws + WS_WRT) + (size_t)l * 32768; const bf16* wrl = wrh + NLAYER * 32768;
    const float* lg = (const float*)A->in[13] + l * 1024; const float* lb = (const float*)A->in[14] + l * 1024;
    LAS float* lnp = (LAS float*)(F.lds + RING_BYTES);
    { const f32x4 v = *(const GAS f32x4*)((F.tid < 256 ? lg : lb) + (F.tid & 255) * 4); *(LAS f32x4*)(lnp + F.tid * 4) = v; }
    { v4u th[8], tl[8];
#pragma unroll
      for (int j = 0; j < 8; ++j) { const int i = F.tid + j * NTHR, e = i >> 7, c = i & 127;
          th[j] = *(const GAS v4u*)(wrh + (size_t)e * 1024 + c * 8); tl[j] = *(const GAS v4u*)(wrl + (size_t)e * 1024 + c * 8); }
#pragma unroll
      for (int j = 0; j < 8; ++j) { const int i = F.tid + j * NTHR, e = i >> 7, c = i & 127;
          *(LAS v4u*)(F.lds + RING_OFF + e * WR_ROWB + c * 16) = th[j]; *(LAS v4u*)(F.lds + RING_OFF + WR_LO_OFF + e * WR_ROWB + c * 16) = tl[j]; } }
    __syncthreads();
    const float* brp = (const float*)A->in[16] + l * 32;
    unsigned* cursor = (unsigned*)(F.ctl + CW_CURSOR + l * 32 * 64);
    LAS int* sc = (LAS int*)(F.lds + RING_OFF + RT_SC_OFF);
    const int gw = F.vcu * NWAVES + F.wave, NGW = F.G * NWAVES, lane = F.lane, row = lane & 15, kq = lane >> 4;
    const LAS unsigned char* wb = F.lds + RING_OFF + row * WR_ROWB + kq * 16;
    for (int bt = gw; bt < TOK / 16; bt += NGW) {
        const size_t roff = (size_t)(bt * 16 + row) * 1024 + kq * 8;
        const bf16* yr = Y + roff;
        float s1 = 0.f, s2 = 0.f;
        { const GAS f32x4* sp = (const GAS f32x4*)(ST + (size_t)(bt * 16 + row) * 32);
#pragma unroll
          for (int i = 0; i < 8; ++i) { const f32x4 p = sp[i]; s1 += p.x; s2 += p.y; s1 += p.z; s2 += p.w; } }
        const float mean = s1 * (1.f / 1024.f); const float var = fmaxf(s2 * (1.f / 1024.f) - mean * mean, 0.f); const float rstd = 1.f / sqrtf(var + LN_EPS);
        f32x4 acc0 = {0.f, 0.f, 0.f, 0.f}, acc1 = acc0;
        unsigned char* xq = X1Q + roff; v2u qprev = {0u, 0u};
#pragma unroll
        for (int hb = 0; hb < 2; ++hb) { v4u ybuf[16];
#pragma unroll
            for (int j = 0; j < 16; ++j) ybuf[j] = *(const GAS v4u*)(yr + 32 * (16 * hb + j));
#pragma unroll
        for (int j = 0; j < 16; ++j) { const int s = 16 * hb + j;
            const v4u yw = ybuf[j];
            f32x4 a = {bf_lo(yw.x), bf_hi(yw.x), bf_lo(yw.y), bf_hi(yw.y)}, b = {bf_lo(yw.z), bf_hi(yw.z), bf_lo(yw.w), bf_hi(yw.w)};
            const f32x4 g0 = *(const LAS f32x4*)(lnp + 32 * s + kq * 8), g1 = *(const LAS f32x4*)(lnp + 32 * s + kq * 8 + 4);
            const f32x4 b0 = *(const LAS f32x4*)(lnp + 1024 + 32 * s + kq * 8), b1 = *(const LAS f32x4*)(lnp + 1024 + 32 * s + kq * 8 + 4);
            a = (a - mean) * rstd * g0 + b0; b = (b - mean) * rstd * g1 + b1;
            v4u h; h.x = pk2(a.x, a.y); h.y = pk2(a.z, a.w); h.z = pk2(b.x, b.y); h.w = pk2(b.z, b.w);
            { v2u q; q.x = pg8::cvt4_fp8(4.f * a.x, 4.f * a.y, 4.f * a.z, 4.f * a.w); q.y = pg8::cvt4_fp8(4.f * b.x, 4.f * b.y, 4.f * b.z, 4.f * b.w);
              if ((s & 1) == 0) qprev = q;
              else { const v4u o = pg8::widen8(qprev, q); const int odd = kq & 1; *(GAS v4u*)(xq + 32 * (s - 1 + odd) - 8 * odd) = o; } }
            v4u lo; lo.x = pk2(a.x - bf_lo(h.x), a.y - bf_hi(h.x)); lo.y = pk2(a.z - bf_lo(h.y), a.w - bf_hi(h.y)); lo.z = pk2(b.x - bf_lo(h.z), b.y - bf_hi(h.z)); lo.w = pk2(b.z - bf_lo(h.w), b.w - bf_hi(h.w));
            const bf16x8 ah = __builtin_bit_cast(bf16x8, h), al = __builtin_bit_cast(bf16x8, lo);
            const bf16x8 wh0 = *(const LAS bf16x8*)(wb + 64 * s), wh1 = *(const LAS bf16x8*)(wb + 16 * WR_ROWB + 64 * s);
            const bf16x8 wl0 = *(const LAS bf16x8*)(wb + WR_LO_OFF + 64 * s), wl1 = *(const LAS bf16x8*)(wb + WR_LO_OFF + 16 * WR_ROWB + 64 * s);
            acc0 = __builtin_amdgcn_mfma_f32_16x16x32_bf16(wh0, ah, acc0, 0, 0, 0); acc1 = __builtin_amdgcn_mfma_f32_16x16x32_bf16(wh1, ah, acc1, 0, 0, 0);
            acc0 = __builtin_amdgcn_mfma_f32_16x16x32_bf16(wh0, al, acc0, 0, 0, 0); acc1 = __builtin_amdgcn_mfma_f32_16x16x32_bf16(wh1, al, acc1, 0, 0, 0);
            acc0 = __builtin_amdgcn_mfma_f32_16x16x32_bf16(wl0, ah, acc0, 0, 0, 0); acc1 = __builtin_amdgcn_mfma_f32_16x16x32_bf16(wl1, ah, acc1, 0, 0, 0);
                } }
        unsigned key[8];
        { const f32x4 br0 = *(const GAS f32x4*)(brp + 4 * kq), br1 = *(const GAS f32x4*)(brp + 16 + 4 * kq);
#pragma unroll
          for (int i = 0; i < 4; ++i) { unsigned u0 = __float_as_uint(acc0[i] + br0[i]), u1 = __float_as_uint(acc1[i] + br1[i]);
              u0 = (u0 & 0x80000000u) ? ~u0 : (u0 | 0x80000000u); u1 = (u1 & 0x80000000u) ? ~u1 : (u1 | 0x80000000u);
              key[i] = (u0 & ~31u) | (unsigned)(31 - (4 * kq + i)); key[4 + i] = (u1 & ~31u) | (unsigned)(31 - (16 + 4 * kq + i)); } }
        float sv[4]; int se[4];
#pragma unroll
        for (int k = 0; k < 4; ++k) { unsigned m = key[0];
#pragma unroll
            for (int i = 1; i < 8; ++i) m = m > key[i] ? m : key[i];
            { auto r = __builtin_amdgcn_permlane16_swap(m, m, false, false); m = r[0] > r[1] ? r[0] : r[1]; }
            { auto r = __builtin_amdgcn_permlane32_swap(m, m, false, false); m = r[0] > r[1] ? r[0] : r[1]; }
            se[k] = 31 - (int)(m & 31u); const unsigned ub = m & ~31u; sv[k] = __uint_as_float((ub & 0x80000000u) ? (ub & 0x7fffffffu) : ~ub);
#pragma unroll
            for (int i = 0; i < 8; ++i) key[i] = (key[i] == m) ? 0u : key[i]; }
        const float e1 = __expf(sv[1] - sv[0]), e2 = __expf(sv[2] - sv[0]), e3 = __expf(sv[3] - sv[0]); const float inv = 1.f / (1.f + e1 + e2 + e3);
        const int my_e = (kq == 0) ? se[0] : (kq == 1) ? se[1] : (kq == 2) ? se[2] : se[3];
        const float my_g = ((kq == 0) ? 1.f : (kq == 1) ? e1 : (kq == 2) ? e2 : e3) * inv;
        unsigned long long mymask = 0ull; int mycnt = 0;
#pragma unroll 1
        for (int e = 0; e < 32; ++e) { const unsigned long long m = __ballot(my_e == e); if (my_e == e) mymask = m; if (lane == e) mycnt = __popcll(m); }
        if (lane < 32) sc[F.wave * 32 + lane] = mycnt;
        __syncthreads();
        if (F.wave == 0 && lane < 32) { int tot = 0;
#pragma unroll
            for (int w = 0; w < 8; ++w) { const int c = sc[w * 32 + lane]; sc[256 + w * 32 + lane] = tot; tot += c; }
            int base = 0; if (tot > 0) base = (int)__hip_atomic_fetch_add(cursor + lane * 64, (unsigned)tot, RLX_AGENT);
#pragma unroll
            for (int w = 0; w < 8; ++w) sc[256 + w * 32 + lane] += base; }
        __syncthreads();
        const int rank = sc[256 + F.wave * 32 + my_e] + __popcll(mymask & ((1ull << lane) - 1ull));
        const int t = bt * 16 + row;
        TOKE[t * 4 + kq] = my_e | (rank << 8); TOKG[t * 4 + kq] = my_g;
        RTOK[(size_t)my_e * CAP + rank] = t;
        __syncthreads();
    }
}

__device__ __forceinline__ void moe_tables(Frame& F, int l) {
    __syncthreads();
    if (F.wave == 0) { const int lane = F.lane;
        const unsigned c = (lane < 32) ? __hip_atomic_load(F.ctl + CW_CURSOR + (l * 32 + lane) * 64, RLX_AGENT) : 0u; const unsigned nbk = (c + 255u) >> 8;
        unsigned incl = nbk;
#pragma unroll
        for (int d = 1; d < 32; d <<= 1) { const unsigned t = (unsigned)__shfl_up((int)incl, d); if ((lane & 31) >= d) incl += t; }
        const unsigned excl = incl - nbk;
        if (lane < 32) { F.MISC[TAB_CNT + lane] = c; F.MISC[TAB_BLK + lane] = excl; for (unsigned rb = excl; rb < incl; ++rb) F.MISC[TAB_RB + rb] = (unsigned)lane; }
        if (lane == 31) F.MISC[TAB_BLK + 32] = incl; }
    __syncthreads();
}

__device__ __forceinline__ void final_phase(Frame& F, ArgsP A, int l, float* OUT, bf16* XBo) {
    typedef int i32x4 __attribute__((ext_vector_type(4)));
    const bf16* Y = (const bf16*)(F.ws + WS_Y); const float* ST = (const float*)(F.ws + WS_STATS) + (size_t)l * TOK * 32; const unsigned char* YS = F.ws + WS_YS;
    const int* TOKE = (const int*)(F.ws + WS_TOKE); const float* TOKG = (const float*)(F.ws + WS_TOKG);
    const int gw = F.vcu * NWAVES + F.wave, NGW = F.G * NWAVES, lane = F.lane;
    f32x4 g1v[2][2], b1v[2][2], lgv[2][2], lbv[2][2];
#pragma unroll
    for (int j = 0; j < 2; ++j)
#pragma unroll
        for (int h = 0; h < 2; ++h) { const int c = l * 1024 + 512 * j + 8 * lane + 4 * h;
            g1v[j][h] = *(const GAS f32x4*)((const float*)A->in[13] + c); b1v[j][h] = *(const GAS f32x4*)((const float*)A->in[14] + c);
            lgv[j][h] = *(const GAS f32x4*)((const float*)A->in[21] + c); lbv[j][h] = *(const GAS f32x4*)((const float*)A->in[22] + c); }
    constexpr int TPI = 4;
    for (int t0 = gw * TPI; t0 < TOK; t0 += NGW * TPI) {
        i32x4 er[TPI]; f32x4 gt[TPI]; float sv[TPI];
#pragma unroll
        for (int q = 0; q < TPI; ++q) { er[q] = *(const GAS i32x4*)(TOKE + (size_t)(t0 + q) * 4); gt[q] = *(const GAS f32x4*)(TOKG + (size_t)(t0 + q) * 4);
            sv[q] = ST[(size_t)(t0 + q) * 32 + (lane & 31)]; }
        v4u yw[TPI][2]; v2u sw[TPI][4][2];
#pragma unroll
        for (int q = 0; q < TPI; ++q) { const GAS v4u* xr = (const GAS v4u*)(Y + (size_t)(t0 + q) * 1024) + lane;
#pragma unroll
            for (int j = 0; j < 2; ++j) yw[q][j] = xr[64 * j]; }
#pragma unroll
        for (int q = 0; q < TPI; ++q)
#pragma unroll
            for (int k = 0; k < 4; ++k) { const int e = er[q][k] & 255, rank = er[q][k] >> 8; const size_t row = (size_t)F.MISC[TAB_BLK + e] * 256 + rank;
                const GAS v2u* yr = (const GAS v2u*)(YS + row * 1024) + lane;
#pragma unroll
                for (int j = 0; j < 2; ++j) sw[q][k][j] = yr[64 * j]; }
#pragma unroll
        for (int q = 0; q < TPI; ++q) { const int t = t0 + q;
            f32x4 v[2][2];
            { const float s1 = wave_sum((lane < 32 && !(lane & 1)) ? sv[q] : 0.f), s2 = wave_sum((lane < 32 && (lane & 1)) ? sv[q] : 0.f);
              const float mean1 = s1 * (1.f / 1024.f); const float var1 = fmaxf(s2 * (1.f / 1024.f) - mean1 * mean1, 0.f); const float rstd1 = 1.f / sqrtf(var1 + LN_EPS);
#pragma unroll
              for (int j = 0; j < 2; ++j) { const v4u w = yw[q][j]; const f32x4 y0 = {bf_lo(w.x), bf_hi(w.x), bf_lo(w.y), bf_hi(w.y)}, y1 = {bf_lo(w.z), bf_hi(w.z), bf_lo(w.w), bf_hi(w.w)};
                  v[j][0] = ((y0 - mean1) * rstd1 * g1v[j][0] + b1v[j][0]) * ALPHA; v[j][1] = ((y1 - mean1) * rstd1 * g1v[j][1] + b1v[j][1]) * ALPHA; } }
#pragma unroll
            for (int k = 0; k < 4; ++k) { const float g = gt[q][k] * (1.f / 64.f);
#pragma unroll
                for (int j = 0; j < 2; ++j) { const v2u w = sw[q][k][j];
                    const f32x2 a0 = __builtin_amdgcn_cvt_pk_f32_fp8((int)w.x, false), a1 = __builtin_amdgcn_cvt_pk_f32_fp8((int)w.x, true), a2 = __builtin_amdgcn_cvt_pk_f32_fp8((int)w.y, false), a3 = __builtin_amdgcn_cvt_pk_f32_fp8((int)w.y, true);
                    v[j][0].x += g * a0.x; v[j][0].y += g * a0.y; v[j][0].z += g * a1.x; v[j][0].w += g * a1.y; v[j][1].x += g * a2.x; v[j][1].y += g * a2.y; v[j][1].z += g * a3.x; v[j][1].w += g * a3.y; } }
            float s = 0.f;
#pragma unroll
            for (int j = 0; j < 2; ++j)
#pragma unroll
                for (int h = 0; h < 2; ++h) s += (v[j][h].x + v[j][h].y) + (v[j][h].z + v[j][h].w);
            const float mean = wave_sum(s) * (1.f / 1024.f); float s2 = 0.f;
#pragma unroll
            for (int j = 0; j < 2; ++j)
#pragma unroll
                for (int h = 0; h < 2; ++h) { v[j][h] = v[j][h] - mean; s2 += (v[j][h].x * v[j][h].x + v[j][h].y * v[j][h].y) + (v[j][h].z * v[j][h].z + v[j][h].w * v[j][h].w); }
            const float rstd = 1.f / sqrtf(wave_sum(s2) * (1.f / 1024.f) + LN_EPS);
#pragma unroll
            for (int j = 0; j < 2; ++j)
#pragma unroll
                for (int h = 0; h < 2; ++h) v[j][h] = v[j][h] * rstd * lgv[j][h] + lbv[j][h];
            if (OUT) { float* xo = OUT + (size_t)t * 1024 + 8 * lane;
#pragma unroll
                for (int j = 0; j < 2; ++j) { *(GAS f32x4*)(xo + 512 * j) = v[j][0]; *(GAS f32x4*)(xo + 512 * j + 4) = v[j][1]; } }
            if (XBo) { bf16* xb = XBo + (size_t)t * 1024 + 8 * lane;
#pragma unroll
                for (int j = 0; j < 2; ++j) { v4u o; o.x = pk2(v[j][0].x, v[j][0].y); o.y = pk2(v[j][0].z, v[j][0].w); o.z = pk2(v[j][1].x, v[j][1].y); o.w = pk2(v[j][1].z, v[j][1].w); *(GAS v4u*)(xb + 512 * j) = o;
                    v2u q; q.x = pg8::cvt4_fp8(4.f * v[j][0].x, 4.f * v[j][0].y, 4.f * v[j][0].z, 4.f * v[j][0].w); q.y = pg8::cvt4_fp8(4.f * v[j][1].x, 4.f * v[j][1].y, 4.f * v[j][1].z, 4.f * v[j][1].w);
                    *(GAS v2u*)(F.ws + WS_XB8 + (size_t)t * 1024 + 8 * lane + 512 * j) = q; } }
        }
    }
}

constexpr int PH_PER_LAYER = 9, NPHASE = 1 + NLAYER * PH_PER_LAYER;
__global__ void __launch_bounds__(NTHR, 2) mega_fwd(Args args) {
    extern __shared__ __attribute__((aligned(16))) unsigned char lds[];
    Frame F;
    F.lds = (LAS unsigned char*)lds;
    F.MISC = (volatile LAS unsigned*)(F.lds + MISC_OFF);
    F.tid = threadIdx.x; F.lane = F.tid & 63; F.wave = __builtin_amdgcn_readfirstlane(F.tid >> 6);
    F.G = gridDim.x; { const int bx = blockIdx.x; F.vcu = (F.G % 8 == 0) ? (bx % 8) * (F.G / 8) + bx / 8 : bx; }
    F.ws = args.ws; F.ctl = (gu32*)(args.ws + WS_CTL);
    for (int u = F.tid; u < (LDS_BYTES - MISC_OFF) / 4; u += NTHR) ((LAS unsigned*)(F.lds + MISC_OFF))[u] = 0u;
    __syncthreads();
#if MK_MULTI
#define GRID_BAR() do { } while (0)
#else
    XcdBarrier bar = xcd_barrier_post((unsigned*)(F.ctl + CW_BAR), F.MISC + 8);
#define GRID_BAR() xcd_barrier(bar)
#endif
    const int lo = args.ph_lo, hi = args.ph_hi;
#ifndef PHMASK
#define PHMASK 0x3ff
#endif
#define PH_ON(n) (((PHMASK) >> (n)) & 1)
#define IN(k) (lo <= (k) && (k) < hi)
#define SEAM(k) do { if (IN((k) + 1)) GRID_BAR(); } while (0)

    if (PH_ON(0) && IN(0)) { ArgsP A = phase_root(F); p0_prologue(F, A); SEAM(0); }

#pragma unroll 1
    for (int l = 0; l < NLAYER; ++l) {
        const int pb = 1 + l * PH_PER_LAYER;
        if (PH_ON(1) && IN(pb + 0)) {
            (void)phase_root(F);
            { pg8::Gemm g{(const pg8::bf16_t*)(F.ws + WS_XB), (const pg8::bf16_t*)(F.ws + WS_WIN) + (size_t)l * INW * 1024, TOK, GATE0, 1024};
              pg8::StaticOrder S; S.init(TOK, GATE0, F.G, (int)blockIdx.x);
              pg8::EpiInProj E{(pg8::bf16_t*)(F.ws + WS_U), (pg8::bf16_t*)(F.ws + WS_Q), (pg8::bf16_t*)(F.ws + WS_K), (pg8::bf16_t*)(F.ws + WS_V), (pg8::bf16_t*)(F.ws + WS_G), (const float*)(F.ws + WS_CS), 0, 1.f};
              { const pg8::TableOrder TO = unit_table(F, S); pg8::gemm_phase<pg8::EpiInProj, pg8::TableOrder, true, true, false>(F.lds + RING_OFF, g, TO, E); } }
            VM_WAIT(); __syncthreads();
            (void)phase_root(F);
            { pg8::Gemm g{(const pg8::bf16_t*)(F.ws + WS_XB8), (const pg8::bf16_t*)(F.ws + WS_WIN8 + (size_t)l * GATEW * 1024), TOK, GATEW, 512};
              pg8::StaticOrder S; S.init(TOK, GATEW, F.G, (int)blockIdx.x);
              pg8::EpiInProj E{(pg8::bf16_t*)(F.ws + WS_U), (pg8::bf16_t*)(F.ws + WS_Q), (pg8::bf16_t*)(F.ws + WS_K), (pg8::bf16_t*)(F.ws + WS_V), (pg8::bf16_t*)(F.ws + WS_G), (const float*)(F.ws + WS_CS), 14, 1.f / 256.f};
              { const pg8::TableOrder TO = unit_table(F, S); pg8::gemm_phase<pg8::EpiInProj, pg8::TableOrder, true, true, false, true>(F.lds + RING_OFF, g, TO, E); } }
            SEAM(pb + 0);
        }
        if (PH_ON(2) && IN(pb + 1)) {
            (void)phase_root(F);
            pool_phase(F);
            VM_WAIT(); __syncthreads();
            { ArgsP A = phase_root(F);
              const float linit = (l == 0) ? 0.2f : (0.8f - 0.6f * 0.74081822068171788f);
              const float a1 = ((const float*)A->in[7])[l * 64 + F.lane] * ((const float*)A->in[8])[l * 64 + F.lane];
              const float a2 = ((const float*)A->in[9])[l * 64 + F.lane] * ((const float*)A->in[10])[l * 64 + F.lane];
              const float lam = expf(wave_sum(a1)) - expf(wave_sum(a2)) + linit;
              const float* swp = (const float*)A->in[11] + l * 128;
              float* blob = (float*)(F.ws + WS_O1) + (size_t)(F.vcu * NWAVES + F.wave) * 4096;
#define ATT_DECODE(idx_, b_, h_, qb_) const int j_##b_ = (idx_) & 7, tm_##b_ = ((idx_) >> 3) & 31, r_##b_ = (idx_) >> 8, bh_##b_ = tm_##b_ * 4 + r_##b_, b_ = bh_##b_ >> 3, h_ = bh_##b_ & 7; \
                  const int qb_ = (r_##b_ == 0) ? j_##b_ : (r_##b_ == 1) ? 7 - j_##b_ : (r_##b_ == 2) ? ((j_##b_ + 4) & 7) : 7 - ((j_##b_ + 4) & 7)
              const attn_body::bf16* Qb = (const attn_body::bf16*)(F.ws + WS_Q); const attn_body::bf16* Kb = (const attn_body::bf16*)(F.ws + WS_K); const attn_body::bf16* Vb = (const attn_body::bf16*)(F.ws + WS_V);
#pragma unroll 1
              for (int rep = 0; rep < REP_ATTN; ++rep) {
                  if (F.vcu < BATCH * 8 * 8) { ATT_DECODE(F.vcu, b0, h0, qb0); (void)qb0; attn_body::attn_prime((long)b0 * SEQ, Kb + h0 * 128, Vb + h0 * 128, (char*)lds + RING_OFF); }
#pragma unroll 1
                  for (int idx = F.vcu; idx < BATCH * 8 * 8; idx += F.G) {
                      ATT_DECODE(idx, b, h, qb);
                      const int nidx = idx + F.G; const int non = nidx < BATCH * 8 * 8; ATT_DECODE(non ? nidx : idx, nb, nh, nqb); (void)nqb;
                      const attn_body::PrimeNext nx{(long)nb * SEQ, Kb + nh * 128, Vb + nh * 128, non};
                      attn_body::diff_attn_unit((long)b * SEQ, qb, Qb + h * 128, Kb + h * 128, Qb + h * 128 + 64, Kb + h * 128 + 64, Vb + h * 128, (attn_body::bf16*)(F.ws + WS_ON) + h * 128, blob, lam, swp, 1.f - linit, (char*)lds + RING_OFF, nx);
                  }
              }
#undef ATT_DECODE
            }
            SEAM(pb + 1);
        }
        if (PH_ON(4) && IN(pb + 3)) {
            (void)phase_root(F);
            { pg8::Gemm g{(const pg8::bf16_t*)(F.ws + WS_DP), (const pg8::bf16_t*)(F.ws + WS_WPF) + (size_t)l * 1024 * 1024, TOK, 1024, 1024,
                          (const pg8::bf16_t*)(F.ws + WS_ON), (const pg8::bf16_t*)(F.ws + WS_WAB) + (size_t)l * 1024 * 1024, 8, 16};
              pg8::StaticOrder S; S.init(TOK, 1024, F.G, (int)blockIdx.x);
              pg8::EpiGateF E{(const unsigned char*)(F.ws + WS_G), (pg8::bf16_t*)(F.ws + WS_MRG)};
              { const pg8::TableOrder TO = unit_table(F, S); pg8::gemm_phase<pg8::EpiGateF, pg8::TableOrder, true, true, false, false, true>(F.lds + RING_OFF, g, TO, E); } }
            SEAM(pb + 3);
        }
        if (PH_ON(5) && IN(pb + 4)) {
            ArgsP A = phase_root(F);
            pg8::Gemm g{(const pg8::bf16_t*)(F.ws + WS_MRG), (const pg8::bf16_t*)(F.ws + WS_WOUT) + (size_t)l * 1024 * 1024, TOK, 1024, 1024};
            pg8::StaticOrder S; S.init(TOK, 1024, F.G, (int)blockIdx.x);
            pg8::EpiOut E{(l == 0) ? (const float*)A->in[0] : nullptr, (const pg8::bf16_t*)(F.ws + WS_XB), (pg8::bf16_t*)(F.ws + WS_Y), (float*)(F.ws + WS_STATS) + (size_t)l * TOK * 32};
            { const pg8::TableOrder TO = unit_table(F, S); pg8::gemm_phase<pg8::EpiOut, pg8::TableOrder, true, true, false>(F.lds + RING_OFF, g, TO, E); }
            SEAM(pb + 4);
        }
        if (PH_ON(6) && IN(pb + 5)) { ArgsP A = phase_root(F); router_phase(F, A, l); SEAM(pb + 5); }
        if (PH_ON(7) && IN(pb + 6)) {
            ArgsP A = phase_root(F);
            moe_tables(F, l);
            pg8::Gemm g{(const pg8::bf16_t*)(F.ws + WS_X1B), (const pg8::bf16_t*)(F.ws + WS_WGU + (size_t)l * NEXP * 2048 * 1024), TOK, 2048, 512};
            pg8::MoeOrder S{(const LAS int*)(F.lds + MISC_OFF) + TAB_BLK, (const LAS int*)(F.lds + MISC_OFF) + TAB_CNT, (const int*)(F.ws + WS_RTOK), 3, F.G, F.vcu, CAP};
            pg8::EpiSwiglu E{F.ws + WS_ACT, (const float*)A->in[18] + (size_t)l * NEXP * 2048};
            pg8::gemm_phase<pg8::EpiSwiglu, pg8::MoeOrder, true, true, true, true>(F.lds + RING_OFF, g, S, E);
            SEAM(pb + 6);
        }
        if (PH_ON(8) && IN(pb + 7)) {
            ArgsP A = phase_root(F);
            if (!IN(pb + 6)) moe_tables(F, l);
            pg8::Gemm g{(const pg8::bf16_t*)(F.ws + WS_ACT), (const pg8::bf16_t*)(F.ws + WS_WD + (size_t)l * NEXP * 1024 * 1024), MAXROWS, 1024, 512};
            pg8::MoeOrder S{(const LAS int*)(F.lds + MISC_OFF) + TAB_BLK, (const LAS int*)(F.lds + MISC_OFF) + TAB_CNT, (const int*)(F.ws + WS_RTOK), 2, F.G, F.vcu, CAP};
            pg8::EpiDown E{F.ws + WS_YS, (const float*)A->in[20] + (size_t)l * NEXP * 1024};
            pg8::gemm_phase<pg8::EpiDown, pg8::MoeOrder, true, true, false, true>(F.lds + RING_OFF, g, S, E);
            SEAM(pb + 7);
        }
        if (PH_ON(9) && IN(pb + 8)) {
            ArgsP A = phase_root(F);
            moe_tables(F, l);
            final_phase(F, A, l, (l == NLAYER - 1) ? A->out : nullptr, (l == NLAYER - 1) ? nullptr : (bf16*)(F.ws + WS_XB));
            if (l != NLAYER - 1) SEAM(pb + 8);
        }
    }
#undef IN
#undef SEAM
}

extern "C" void kernel_launch(void* const* d_in, const int* in_sizes, int n_in, void* d_out, int out_size, void* d_ws, size_t ws_size, hipStream_t stream) {
    static int grid = 0;
    if (grid == 0) {
        if (n_in != 23 || in_sizes[0] != TOK * DMODEL || out_size != TOK * DMODEL || ws_size < WS_END) {
            fprintf(stderr, "kernel_launch: unexpected shapes (n_in %d, in0 %d, out %d, ws %zu < %zu); nothing launched\n", n_in, n_in > 0 ? in_sizes[0] : -1, out_size, ws_size, (size_t)WS_END); grid = -1; return; }
        int dev = 0, cus = 0, per_cu = 0;
        if (hipGetDevice(&dev) != hipSuccess || hipDeviceGetAttribute(&cus, hipDeviceAttributeMultiprocessorCount, dev) != hipSuccess) { fprintf(stderr, "kernel_launch: device query failed\n"); grid = -1; return; }
        if (hipFuncSetAttribute((const void*)mega_fwd, hipFuncAttributeMaxDynamicSharedMemorySize, LDS_BYTES) != hipSuccess) { fprintf(stderr, "kernel_launch: hipFuncSetAttribute failed\n"); grid = -1; return; }
        if (hipOccupancyMaxActiveBlocksPerMultiprocessor(&per_cu, (const void*)mega_fwd, NTHR, LDS_BYTES) != hipSuccess || per_cu < 1)
            fprintf(stderr, "kernel_launch: note: occupancy query reports %d workgroups per CU\n", per_cu);
        (void)hipGetLastError();
        grid = cus;
    }
    if (grid < 0) return;
    if (hipMemsetAsync((char*)d_ws + WS_CTL, 0, CTL_ZERO_BYTES, stream) != hipSuccess) { fprintf(stderr, "kernel_launch: memset failed\n"); return; }
    Args a{};
    for (int i = 0; i < 23; ++i) a.in[i] = d_in[i];
    a.out = (float*)d_out; a.ws = (unsigned char*)d_ws;
#if MK_MULTI
    for (int p = 0; p < NPHASE; ++p) { a.ph_lo = p; a.ph_hi = p + 1; hipLaunchKernelGGL(mega_fwd, dim3(grid), dim3(NTHR), LDS_BYTES, stream, a); }
#else
    a.ph_lo = 0; a.ph_hi = NPHASE;
    hipLaunchKernelGGL(mega_fwd, dim3(grid), dim3(NTHR), LDS_BYTES, stream, a);
    if (PROBE_PHASE >= 0) { a.ph_lo = PROBE_PHASE; a.ph_hi = PROBE_PHASE + 1; hipLaunchKernelGGL(mega_fwd, dim3(grid), dim3(NTHR), LDS_BYTES, stream, a); }
#endif
    const hipError_t le = hipPeekAtLastError();
    if (le != hipSuccess) fprintf(stderr, "kernel_launch: launch failed: %s\n", hipGetErrorName(le));
}
```
